# Optimizing an MI355X kernel written in HIP

```python
import math
import jax, jax.numpy as jnp
from jax import lax
import numpy as np

D_MODEL = 4096
BATCH = 4
SEQ = 4096
DEPTH = 1

HEAD_DIM = 128
HEADS_PER_GROUP = 8
PATTERNS = ((128, 1), (512, 4), (2048, 16))
N_GROUPS = len(PATTERNS)
ATT_W = N_GROUPS * HEADS_PER_GROUP * HEAD_DIM
BLK = 128
LRU_W = D_MODEL
LRU_BLOCKS = 16
LRU_BW = LRU_W // LRU_BLOCKS
LRU_C = 8.0
LRU_CONV = 4
FFN_DIM = 3 * D_MODEL
FFN_CONV = 3
PLE_DIM = 256
IN_SIZES = (ATT_W, ATT_W, ATT_W, LRU_W, LRU_W, D_MODEL, D_MODEL)
IN_COLS = sum(IN_SIZES)
EPS = 1e-6

kernel_name = "hybrid_dilated_attn_rglru_convffn_ple"


def rmsnorm(x, g):
    xf = x.astype(jnp.float32)
    y = xf * lax.rsqrt(jnp.mean(xf * xf, axis=-1, keepdims=True) + EPS)
    return (y * g.astype(jnp.float32)).astype(x.dtype)


def causal_dwconv(x, w, b):
    K = w.shape[0]
    S = x.shape[1]
    xp = jnp.pad(x, ((0, 0), (K - 1, 0), (0, 0)))
    y = xp[:, 0:S] * w[0]
    for k in range(1, K):
        y = y + xp[:, k:k + S] * w[k]
    return y + b


def dilated_causal_attention(q, k, v, dilation, n_back):
    B, S, H, Dh = q.shape
    L = S // dilation
    nb = -(-L // BLK)
    pad_l = nb * BLK - L

    def sub(a):
        return a.reshape(B, L, dilation, H, Dh).transpose(0, 2, 3, 1, 4)

    qs = jnp.pad(sub(q), ((0, 0), (0, 0), (0, 0), (0, pad_l), (0, 0))).reshape(B, dilation, H, nb, BLK, Dh)

    def band(a):
        a = jnp.pad(sub(a), ((0, 0), (0, 0), (0, 0), (BLK, pad_l), (0, 0))).reshape(B, dilation, H, nb + 1, BLK, Dh)
        return jnp.concatenate([a[:, :, :, :-1], a[:, :, :, 1:]], axis=-2)

    kb, vb = band(k), band(v)
    s = jnp.einsum('brhcid,brhcjd->brhcij', qs, kb).astype(jnp.float32) * (Dh ** -0.5)
    qi = jnp.arange(BLK)[:, None]
    km = jnp.arange(2 * BLK)[None, :]
    cb = jnp.arange(nb)[:, None, None]
    back = BLK + qi - km
    valid = (back >= 0) & (back <= n_back) & ((cb - 1) * BLK + km >= 0)
    s = jnp.where(valid, s, jnp.finfo(jnp.float32).min)
    mx = jnp.max(s, axis=-1, keepdims=True)
    pr = jnp.exp(s - mx)
    den = jnp.sum(pr, axis=-1)
    o = jnp.einsum('brhcij,brhcjd->brhcid', pr, vb.astype(jnp.float32)) / den[..., None]
    lse = mx[..., 0] + jnp.log(den)
    o = o.reshape(B, dilation, H, nb * BLK, Dh)[:, :, :, :L].transpose(0, 3, 1, 2, 4).reshape(B, S, H, Dh)
    lse = lse.reshape(B, dilation, H, nb * BLK)[:, :, :, :L].transpose(0, 3, 1, 2).reshape(B, S, H)
    return o, lse


def rglru(xc, r, i, lam):
    log_a = -LRU_C * r.astype(jnp.float32) * jax.nn.softplus(-lam.astype(jnp.float32))
    a = jnp.exp(log_a)
    mult = jnp.sqrt(-jnp.expm1(2.0 * log_a))
    b = mult * i.astype(jnp.float32) * xc.astype(jnp.float32)

    def step(h, ab):
        a_t, b_t = ab
        h = a_t * h + b_t
        return h, h

    h0 = jnp.zeros((xc.shape[0], xc.shape[2]), jnp.float32)
    _, hs = lax.scan(step, h0, (a.transpose(1, 0, 2), b.transpose(1, 0, 2)))
    return hs.transpose(1, 0, 2)


def setup_inputs(seed: int = 0) -> dict:
    key = jax.random.key(seed)
    ks = jax.random.split(key, 26)
    f32 = jnp.float32

    def nrm(k, shape, fan_in):
        return jax.random.normal(k, shape, f32) * (fan_in ** -0.5)

    def gain(k, shape):
        return 1.0 + 0.05 * jax.random.normal(k, shape, f32)

    def bias(k, shape):
        return 0.01 * jax.random.normal(k, shape, f32)

    u = jax.random.uniform(ks[11], (DEPTH, LRU_W), f32, minval=0.9, maxval=0.999)
    a0 = u ** (1.0 / LRU_C)
    lru_lambda = jnp.log(a0) - jnp.log1p(-a0)
    return {
        "x": jax.random.normal(ks[0], (BATCH, SEQ, D_MODEL), f32),
        "p": jax.random.normal(ks[1], (DEPTH, BATCH, SEQ, PLE_DIM), f32),
        "mix_norm_g": gain(ks[2], (DEPTH, D_MODEL)),
        "w_in": nrm(ks[3], (DEPTH, D_MODEL, IN_COLS), D_MODEL),
        "lru_conv_w": nrm(ks[4], (DEPTH, LRU_CONV, LRU_W), LRU_CONV),
        "lru_conv_b": bias(ks[5], (DEPTH, LRU_W)),
        "w_rgate": nrm(ks[6], (DEPTH, LRU_BLOCKS, LRU_BW, LRU_BW), LRU_BW),
        "b_rgate": bias(ks[7], (DEPTH, LRU_W)),
        "w_igate": nrm(ks[8], (DEPTH, LRU_BLOCKS, LRU_BW, LRU_BW), LRU_BW),
        "b_igate": bias(ks[9], (DEPTH, LRU_W)),
        "lru_lambda": lru_lambda,
        "w_att_branch": nrm(ks[12], (DEPTH, ATT_W, D_MODEL), ATT_W),
        "w_lru_branch": nrm(ks[13], (DEPTH, LRU_W, D_MODEL), LRU_W),
        "w_out": nrm(ks[14], (DEPTH, D_MODEL, D_MODEL), D_MODEL),
        "ffn_norm_g": gain(ks[15], (DEPTH, D_MODEL)),
        "w_up": nrm(ks[16], (DEPTH, D_MODEL, 2 * FFN_DIM), D_MODEL),
        "ffn_conv_w": nrm(ks[17], (DEPTH, FFN_CONV, 2 * FFN_DIM), FFN_CONV),
        "ffn_conv_b": bias(ks[18], (DEPTH, 2 * FFN_DIM)),
        "w_down": nrm(ks[19], (DEPTH, FFN_DIM, D_MODEL), FFN_DIM),
        "ple_proj": nrm(ks[20], (DEPTH, PLE_DIM, D_MODEL), PLE_DIM),
        "ple_norm_g": gain(ks[21], (DEPTH, D_MODEL)),
        "ple_gate_norm_g": gain(ks[22], (DEPTH, D_MODEL)),
        "ple_gate_w": nrm(ks[23], (DEPTH, D_MODEL, D_MODEL), D_MODEL),
        "final_norm_g": gain(ks[24], (D_MODEL,)),
    }


def reference(x, p, mix_norm_g, w_in, lru_conv_w, lru_conv_b, w_rgate, b_rgate, w_igate, b_igate,
              lru_lambda, w_att_branch, w_lru_branch, w_out, ffn_norm_g, w_up, ffn_conv_w, ffn_conv_b,
              w_down, ple_proj, ple_norm_g, ple_gate_norm_g, ple_gate_w, final_norm_g):
    B, S, _ = x.shape
    offs = [int(o) for o in np.cumsum(IN_SIZES)[:-1]]
    for l in range(DEPTH):
        h = rmsnorm(x, mix_norm_g[l])
        proj = h @ w_in[l]
        q, k, v, xr, yr, ga, gr = jnp.split(proj, offs, axis=-1)
        q = q.reshape(B, S, N_GROUPS, HEADS_PER_GROUP, HEAD_DIM)
        k = k.reshape(B, S, N_GROUPS, HEADS_PER_GROUP, HEAD_DIM)
        v = v.reshape(B, S, N_GROUPS, HEADS_PER_GROUP, HEAD_DIM)
        outs, lses = [], []
        for g, (win, dil) in enumerate(PATTERNS):
            o_g, lse_g = dilated_causal_attention(q[:, :, g], k[:, :, g], v[:, :, g], dil, win // dil)
            outs.append(o_g)
            lses.append(lse_g)
        o = jnp.stack(outs, axis=2)
        wgt = jax.nn.softmax(jnp.stack(lses, axis=2), axis=2)
        att = (o * wgt[..., None]).astype(x.dtype).reshape(B, S, ATT_W)

        xc = causal_dwconv(xr, lru_conv_w[l], lru_conv_b[l])
        xcb = xc.reshape(B, S, LRU_BLOCKS, LRU_BW)
        r = jax.nn.sigmoid(jnp.einsum('bsni,nij->bsnj', xcb, w_rgate[l]).reshape(B, S, LRU_W) + b_rgate[l])
        i = jax.nn.sigmoid(jnp.einsum('bsni,nij->bsnj', xcb, w_igate[l]).reshape(B, S, LRU_W) + b_igate[l])
        lru = rglru(xc, r, i, lru_lambda[l]).astype(x.dtype) * jax.nn.gelu(yr)

        merged = jax.nn.sigmoid(ga) * (att @ w_att_branch[l]) + jax.nn.sigmoid(gr) * (lru @ w_lru_branch[l])
        x = x + merged @ w_out[l]

        h = rmsnorm(x, ffn_norm_g[l])
        up = causal_dwconv(h @ w_up[l], ffn_conv_w[l], ffn_conv_b[l])
        gate, val = jnp.split(up, 2, axis=-1)
        x = x + (jax.nn.gelu(gate) * val) @ w_down[l]

        e = rmsnorm(p[l].astype(x.dtype) @ ple_proj[l], ple_norm_g[l])
        x = x + jax.nn.sigmoid(rmsnorm(x, ple_gate_norm_g[l]) @ ple_gate_w[l]) * e
    return rmsnorm(x, final_norm_g)
```

```cpp
#include <hip/hip_runtime.h>
#include <cstdio>
#include <cstdint>
namespace pg8 {
#define PG8_LAS __attribute__((address_space(3)))
typedef unsigned short bf16_t;
typedef short bf16x8 __attribute__((ext_vector_type(8)));
typedef float f32x4 __attribute__((ext_vector_type(4)));
typedef unsigned u32x4 __attribute__((ext_vector_type(4)));
constexpr int BM = 256, BK = 64, HALF = 128, HTB = HALF * BK * 2  , STAGE_BYTES = 8 * HTB, NXCD = 8, WGM = 8;

__host__ __device__ __forceinline__ int lds_byte(int r, int c) { const int st = (r >> 4) * 2 + (c >> 5), rr = r & 15, cc = c & 31, ob = rr * 64 + cc * 2; return st * 1024 + (ob ^ (((ob >> 9) & 1) << 5)); }
__host__ __device__ __forceinline__ void stage_rc(int b, int& R, int& C) { const int st = b / 1024, sb = b % 1024, swz = sb ^ (((sb >> 9) & 1) << 5); R = (st >> 1) * 16 + swz / 64; C = (st & 1) * 32 + (swz % 64) / 2; }
__host__ __device__ __forceinline__ int perm32(int rho) { const int n = rho >> 4, i = rho & 15; return 8 * (i >> 2) + 4 * n + (i & 3); }

struct Unit { int pm, pn; };
struct Gemm { const bf16_t* A; const bf16_t* Bt; int M, N, K; };

struct StaticOrder {
    int nM, nN, nwg, G, c;
    __host__ __device__ void init(int M, int N, int G_, int c_) { nM = M / BM; nN = N / BM; nwg = nM * nN; G = G_; c = c_; }
    __host__ __device__ bool next(int i, Unit& u) const {
        const long L = (long)i * G + c; if (L >= nwg) return false;
        int wgid = (int)L; { const int q = nwg / NXCD, r = nwg % NXCD, xcd = wgid % NXCD, off = wgid / NXCD; wgid = (xcd < r ? xcd * (q + 1) : r * (q + 1) + (xcd - r) * q) + off; }
        const int nig = WGM * nN, gid = wgid / nig, fm = gid * WGM, gsz = (nM - fm) < WGM ? (nM - fm) : WGM;
        u.pm = fm + ((wgid % nig) % gsz); u.pn = (wgid % nig) / gsz; return true;
    }
    __device__ __forceinline__ void a_ready(const Unit&) const {}
    __device__ __forceinline__ void done(const Unit&) const {}
};

__device__ __forceinline__ unsigned cvt_pk_bf16(float lo, float hi) { unsigned r; asm volatile("v_cvt_pk_bf16_f32 %0, %1, %2" : "=v"(r) : "v"(lo), "v"(hi)); return r; }
typedef float f32x2 __attribute__((ext_vector_type(2)));
__device__ __forceinline__ float sigmoid_f(float v) { return __builtin_amdgcn_rcpf(1.0f + __builtin_amdgcn_exp2f(-1.4426950408889634f * v)); }
__device__ __forceinline__ float gelu_tanh_f(float v) { const float u = v * (1.0f + 0.044715f * v * v); return v * __builtin_amdgcn_rcpf(1.0f + __builtin_amdgcn_exp2f(-2.3022081984901087f * u)); }
__device__ __forceinline__ float bf_lo(unsigned w) { return __uint_as_float(w << 16); }
__device__ __forceinline__ float bf_hi(unsigned w) { return __uint_as_float(w & 0xffff0000u); }
typedef unsigned u32x2 __attribute__((ext_vector_type(2)));
constexpr float RMS_EPS = 1e-6f;
__device__ __forceinline__ float rstd_of(float ss) { return __builtin_amdgcn_rsqf(ss * (1.0f / 4096.0f) + RMS_EPS); }

struct EpiProj {
    static constexpr bool PERM = true, AFTER_DRAIN = false;
    bf16_t *Q, *XR; const float* rowss;
    __device__ __forceinline__ void operator()(f32x4 (&acc)[2][2][4][2], const Unit& u, int wr, int wc, int fr, int fq) const {
        asm volatile("" : "+v"(fr), "+v"(fq));
        int colt = u.pn * BM; bf16_t* base; int ldc, act;
        if (colt < 9216) { const int t = colt / 3072; base = Q + (size_t)t * (size_t)50331648; colt -= t * 3072; ldc = 3072; act = 0; }
        else { const int t = (colt - 9216) / 4096; base = XR + (size_t)t * (size_t)67108864; colt -= 9216 + t * 4096; ldc = 4096; act = t > 2 ? 2 : t; }
        const int row0 = u.pm * BM + wr * 64 + fr, col0 = colt + wc * 32 + 8 * fq;
#pragma unroll
        for (int ai = 0; ai < 2; ++ai)
#pragma unroll
            for (int m = 0; m < 4; ++m) { const int row = row0 + ai * HALF + m * 16; const float rs = rstd_of(rowss[row]); bf16_t* rowp = base + (size_t)row * ldc + col0;
#pragma unroll
                for (int bj = 0; bj < 2; ++bj) { f32x4 v0 = acc[ai][bj][m][0] * rs, v1 = acc[ai][bj][m][1] * rs;
                    if (act == 1) {
#pragma unroll
                        for (int j = 0; j < 4; ++j) { v0[j] = gelu_tanh_f(v0[j]); v1[j] = gelu_tanh_f(v1[j]); } }
                    else if (act == 2) {
#pragma unroll
                        for (int j = 0; j < 4; ++j) { v0[j] = sigmoid_f(v0[j]); v1[j] = sigmoid_f(v1[j]); } }
                    u32x4 w; w.x = cvt_pk_bf16(v0[0], v0[1]); w.y = cvt_pk_bf16(v0[2], v0[3]); w.z = cvt_pk_bf16(v1[0], v1[1]); w.w = cvt_pk_bf16(v1[2], v1[3]);
                    *(u32x4*)(rowp + bj * HALF) = w; } }
    }
};
struct EpiResid {
    static constexpr bool PERM = false, AFTER_DRAIN = false;
    const float* base; float* out; bf16_t* outb; float* rowss;
    __device__ __forceinline__ void operator()(f32x4 (&acc)[2][2][4][2], const Unit& u, int wr, int wc, int fr, int fq) const {
        asm volatile("" : "+v"(fr), "+v"(fq));
        const int row0 = u.pm * BM + wr * 64 + fr, col0 = u.pn * BM + wc * 32 + 4 * fq;
#pragma unroll
        for (int ai = 0; ai < 2; ++ai)
#pragma unroll
            for (int m = 0; m < 4; ++m) { const int row = row0 + ai * HALF + m * 16; const size_t off = (size_t)row * 4096 + col0; float s = 0.f;
#pragma unroll
                for (int bj = 0; bj < 2; ++bj)
#pragma unroll
                    for (int n = 0; n < 2; ++n) { const size_t o = off + bj * HALF + n * 16; const f32x4 bs = *(const f32x4*)(base + o); const f32x4 x = bs + acc[ai][bj][m][n];
                        *(f32x4*)(out + o) = x; s += (x[0] * x[0] + x[1] * x[1]) + (x[2] * x[2] + x[3] * x[3]);
                        u32x2 w; w.x = cvt_pk_bf16(x[0], x[1]); w.y = cvt_pk_bf16(x[2], x[3]); *(u32x2*)(outb + o) = w; }
                s += __shfl_xor(s, 16); s += __shfl_xor(s, 32);
                if (fq == 0) __hip_atomic_fetch_add(rowss + row, s, __ATOMIC_RELAXED, __HIP_MEMORY_SCOPE_AGENT); }
    }
};
struct EpiGateT {
    static constexpr bool PERM = false, AFTER_DRAIN = false;
    const bf16_t* G; float* T;
    __device__ __forceinline__ void operator()(f32x4 (&acc)[2][2][4][2], const Unit& u, int wr, int wc, int fr, int fq) const {
        asm volatile("" : "+v"(fr), "+v"(fq));
        const int row0 = u.pm * BM + wr * 64 + fr, col0 = u.pn * BM + wc * 32 + 4 * fq;
#pragma unroll
        for (int ai = 0; ai < 2; ++ai)
#pragma unroll
            for (int m = 0; m < 4; ++m) { const size_t off = (size_t)(row0 + ai * HALF + m * 16) * 4096 + col0;
#pragma unroll
                for (int bj = 0; bj < 2; ++bj)
#pragma unroll
                    for (int n = 0; n < 2; ++n) { const size_t o = off + bj * HALF + n * 16; const u32x2 g = *(const u32x2*)(G + o);
                        const f32x4 gv = {bf_lo(g.x), bf_hi(g.x), bf_lo(g.y), bf_hi(g.y)}; *(f32x4*)(T + o) = gv * acc[ai][bj][m][n]; } }
    }
};
struct EpiMerge {
    static constexpr bool PERM = false, AFTER_DRAIN = false;
    const bf16_t* G; const float* T; bf16_t* O;
    __device__ __forceinline__ void operator()(f32x4 (&acc)[2][2][4][2], const Unit& u, int wr, int wc, int fr, int fq) const {
        asm volatile("" : "+v"(fr), "+v"(fq));
        const int row0 = u.pm * BM + wr * 64 + fr, col0 = u.pn * BM + wc * 32 + 4 * fq;
#pragma unroll
        for (int ai = 0; ai < 2; ++ai)
#pragma unroll
            for (int m = 0; m < 4; ++m) { const size_t off = (size_t)(row0 + ai * HALF + m * 16) * 4096 + col0;
#pragma unroll
                for (int bj = 0; bj < 2; ++bj)
#pragma unroll
                    for (int n = 0; n < 2; ++n) { const size_t o = off + bj * HALF + n * 16; const u32x2 g = *(const u32x2*)(G + o); const f32x4 t = *(const f32x4*)(T + o);
                        const f32x4 gv = {bf_lo(g.x), bf_hi(g.x), bf_lo(g.y), bf_hi(g.y)}; const f32x4 x = t + gv * acc[ai][bj][m][n];
                        u32x2 w; w.x = cvt_pk_bf16(x[0], x[1]); w.y = cvt_pk_bf16(x[2], x[3]); *(u32x2*)(O + o) = w; } }
    }
};
struct EpiBf16Stat {
    static constexpr bool PERM = true, AFTER_DRAIN = false;
    bf16_t* O; float* rowss;
    __device__ __forceinline__ void operator()(f32x4 (&acc)[2][2][4][2], const Unit& u, int wr, int wc, int fr, int fq) const {
        asm volatile("" : "+v"(fr), "+v"(fq));
        const int row0 = u.pm * BM + wr * 64 + fr, col0 = u.pn * BM + wc * 32 + 8 * fq;
#pragma unroll
        for (int ai = 0; ai < 2; ++ai)
#pragma unroll
            for (int m = 0; m < 4; ++m) { const int row = row0 + ai * HALF + m * 16; bf16_t* rowp = O + (size_t)row * 4096 + col0; float s = 0.f;
#pragma unroll
                for (int bj = 0; bj < 2; ++bj) { const f32x4 v0 = acc[ai][bj][m][0], v1 = acc[ai][bj][m][1];
                    s += (v0[0] * v0[0] + v0[1] * v0[1]) + (v0[2] * v0[2] + v0[3] * v0[3]) + (v1[0] * v1[0] + v1[1] * v1[1]) + (v1[2] * v1[2] + v1[3] * v1[3]);
                    u32x4 w; w.x = cvt_pk_bf16(v0[0], v0[1]); w.y = cvt_pk_bf16(v0[2], v0[3]); w.z = cvt_pk_bf16(v1[0], v1[1]); w.w = cvt_pk_bf16(v1[2], v1[3]);
                    *(u32x4*)(rowp + bj * HALF) = w; }
                s += __shfl_xor(s, 16); s += __shfl_xor(s, 32);
                if (fq == 0) __hip_atomic_fetch_add(rowss + row, s, __ATOMIC_RELAXED, __HIP_MEMORY_SCOPE_AGENT); }
    }
};
struct EpiPle {
    static constexpr bool PERM = false, AFTER_DRAIN = false;
    const float* X2; const bf16_t* Eraw; const float* rowss2; const float* rowsse; const float* gple; float* out; float* rowss3;
    __device__ __forceinline__ void operator()(f32x4 (&acc)[2][2][4][2], const Unit& u, int wr, int wc, int fr, int fq) const {
        asm volatile("" : "+v"(fr), "+v"(fq));
        const int row0 = u.pm * BM + wr * 64 + fr, col0 = u.pn * BM + wc * 32 + 4 * fq;
        f32x4 gp[2][2];
#pragma unroll
        for (int bj = 0; bj < 2; ++bj)
#pragma unroll
            for (int n = 0; n < 2; ++n) gp[bj][n] = *(const f32x4*)(gple + col0 + bj * HALF + n * 16);
#pragma unroll
        for (int ai = 0; ai < 2; ++ai)
#pragma unroll
            for (int m = 0; m < 4; ++m) { const int row = row0 + ai * HALF + m * 16; const size_t off = (size_t)row * 4096 + col0; float s = 0.f;
                const float rs2 = rstd_of(rowss2[row]), rse = rstd_of(rowsse[row]);
#pragma unroll
                for (int bj = 0; bj < 2; ++bj)
#pragma unroll
                    for (int n = 0; n < 2; ++n) { const size_t o = off + bj * HALF + n * 16; const u32x2 e = *(const u32x2*)(Eraw + o); const f32x4 xb = *(const f32x4*)(X2 + o);
                        const f32x4 ev = {bf_lo(e.x), bf_hi(e.x), bf_lo(e.y), bf_hi(e.y)}; const f32x4 z = acc[ai][bj][m][n] * rs2; f32x4 x;
#pragma unroll
                        for (int j = 0; j < 4; ++j) x[j] = xb[j] + sigmoid_f(z[j]) * (ev[j] * rse * gp[bj][n][j]);
                        *(f32x4*)(out + o) = x; s += (x[0] * x[0] + x[1] * x[1]) + (x[2] * x[2] + x[3] * x[3]); }
                s += __shfl_xor(s, 16); s += __shfl_xor(s, 32);
                if (fq == 0) __hip_atomic_fetch_add(rowss3 + row, s, __ATOMIC_RELAXED, __HIP_MEMORY_SCOPE_AGENT); }
    }
};
struct EpiUpConv {
    static constexpr bool PERM = true, AFTER_DRAIN = false;
    const float* rowss1; const float* cw; const float* cbias; bf16_t* ACT; float* HALO; float* HEAD; PG8_LAS float* xh;
    __device__ __forceinline__ void operator()(f32x4 (&acc)[2][2][4][2], const Unit& u, int wr, int wc, int fr, int fq) const {
        asm volatile("" : "+v"(fr), "+v"(fq));
        const int row0 = u.pm * BM + wr * 64 + fr, tcol = wc * 32 + 8 * fq;
        const int lane = fq * 16 + fr;
#pragma unroll
        for (int ai = 0; ai < 2; ++ai)
#pragma unroll
            for (int m = 0; m < 4; ++m) { const float rs = rstd_of(rowss1[row0 + ai * HALF + m * 16]);
#pragma unroll
                for (int bj = 0; bj < 2; ++bj)
#pragma unroll
                    for (int n = 0; n < 2; ++n) acc[ai][bj][m][n] = acc[ai][bj][m][n] * rs; }
        if (fr >= 14) {
            PG8_LAS float* xw = xh + (wr * 2 + (fr - 14)) * 256 + tcol;
            float* hw = HALO + ((size_t)u.pm * 2 + (fr - 14)) * 24576 + u.pn * BM + tcol;
#pragma unroll
            for (int bj = 0; bj < 2; ++bj)
#pragma unroll
                for (int n = 0; n < 2; ++n) { *(PG8_LAS f32x4*)(xw + 128 * bj + 4 * n) = acc[0][bj][3][n];
                    if (wr == 0) *(PG8_LAS f32x4*)(xw + 1024 + 128 * bj + 4 * n) = acc[1][bj][3][n]; else *(f32x4*)(hw + 128 * bj + 4 * n) = acc[1][bj][3][n]; }
        }
        if (fr < 2 && wr == 0) {
#pragma unroll
            for (int bj = 0; bj < 2; ++bj)
#pragma unroll
                for (int n = 0; n < 2; ++n) { const int c = 128 * bj + tcol + 4 * n; *(f32x4*)(HEAD + ((size_t)u.pm * 2 + fr) * 24576 + u.pn * BM + c) = acc[0][bj][0][n]; }
        }
        asm volatile("s_waitcnt lgkmcnt(0)" ::: "memory"); __builtin_amdgcn_s_barrier(); asm volatile("" ::: "memory");
        const int s1 = (lane & 48) | ((fr + 15) & 15), s2 = (lane & 48) | ((fr + 14) & 15);
        const int gcol0 = u.pn * 128 + tcol;
#pragma unroll
        for (int n = 0; n < 2; ++n) {
            f32x4 wg[3], wv[3], bg, bv;
#pragma unroll
            for (int k = 0; k < 3; ++k) { wg[k] = *(const f32x4*)(cw + (size_t)k * 24576 + gcol0 + 4 * n); wv[k] = *(const f32x4*)(cw + (size_t)k * 24576 + 12288 + gcol0 + 4 * n); }
            bg = *(const f32x4*)(cbias + gcol0 + 4 * n); bv = *(const f32x4*)(cbias + 12288 + gcol0 + 4 * n);
#pragma unroll
            for (int ai = 0; ai < 2; ++ai) { const int k = 2 * ai + wr;
                f32x4 pg = {0.f, 0.f, 0.f, 0.f}, pv = {0.f, 0.f, 0.f, 0.f};
                if (k >= 1 && fr >= 14) { pg = *(const PG8_LAS f32x4*)(xh + ((k - 1) * 2 + (fr - 14)) * 256 + tcol + 4 * n); pv = *(const PG8_LAS f32x4*)(xh + ((k - 1) * 2 + (fr - 14)) * 256 + 128 + tcol + 4 * n); }
                f32x4 r1pg, r2pg, r1pv, r2pv;
#pragma unroll
                for (int j = 0; j < 4; ++j) { r1pg[j] = __shfl(pg[j], s1); r2pg[j] = __shfl(pg[j], s2); r1pv[j] = __shfl(pv[j], s1); r2pv[j] = __shfl(pv[j], s2); }
#pragma unroll
                for (int m = 0; m < 4; ++m) { const f32x4 cg = acc[ai][0][m][n], cv = acc[ai][1][m][n]; f32x4 r1g, r2g, r1v, r2v, o;
#pragma unroll
                    for (int j = 0; j < 4; ++j) { r1g[j] = __shfl(cg[j], s1); r2g[j] = __shfl(cg[j], s2); r1v[j] = __shfl(cv[j], s1); r2v[j] = __shfl(cv[j], s2); }
#pragma unroll
                    for (int j = 0; j < 4; ++j) { const float p1g = fr >= 1 ? r1g[j] : r1pg[j], p2g = fr >= 2 ? r2g[j] : r2pg[j], p1v = fr >= 1 ? r1v[j] : r1pv[j], p2v = fr >= 2 ? r2v[j] : r2pv[j];
                        const float yg = wg[0][j] * p2g + wg[1][j] * p1g + wg[2][j] * cg[j] + bg[j], yv = wv[0][j] * p2v + wv[1][j] * p1v + wv[2][j] * cv[j] + bv[j];
                        o[j] = gelu_tanh_f(yg) * yv; }
                    u32x2 w; w.x = cvt_pk_bf16(o[0], o[1]); w.y = cvt_pk_bf16(o[2], o[3]);
                    *(u32x2*)(ACT + (size_t)(row0 + ai * HALF + m * 16) * 12288 + gcol0 + 4 * n) = w;
                    r1pg = r1g; r2pg = r2g; r1pv = r1v; r2pv = r2v; }
            }
        }
    }
};

template <class Epi, class Sched, bool ALIGN_EPI = false, bool SP2 = false>
__device__ __forceinline__ void gemm_phase(PG8_LAS unsigned char* lds, const Gemm g, const Sched& S, const Epi& E, const int wid  ) {
    int lane = (int)__builtin_amdgcn_mbcnt_hi(~0u, __builtin_amdgcn_mbcnt_lo(~0u, 0u)); asm volatile("" : "+v"(lane));
    const int tid = wid * 64 + lane, wr = wid >> 2, wc = wid & 3, fr = lane & 15, fq = lane >> 4;
    const int K = g.K, nt = K / BK;
    unsigned voffA[2], voffB[2];
#pragma unroll
    for (int i = 0; i < 2; ++i) { int R, C; stage_rc(tid * 16 + i * 8192, R, C); const int Rb = Epi::PERM ? ((R & ~31) + perm32(R & 31)) : R;
        voffA[i] = (unsigned)(R * K + C) * 2u; voffB[i] = (unsigned)(Rb * K + C) * 2u; }
    const size_t kstep = (size_t)(BK * 2);
    const size_t hstep = (size_t)HALF * K * 2;
    const size_t tstep = 2 * hstep;
    const unsigned ldsw = (unsigned)wid * 1024u;
    const int aoff = lds_byte(wr * 64 + fr, fq * 8), boff = lds_byte(wc * 32 + fr, fq * 8);
#define PG8_SA(b, h) (((b) * 2 + (h)) * HTB)
#define PG8_SB(b, h) ((4 + (b) * 2 + (h)) * HTB)
#define PG8_STAGE(bufoff, gbase, voff) do { _Pragma("unroll") for (int _i = 0; _i < 2; ++_i) \
        __builtin_amdgcn_global_load_lds((const unsigned*)((const char*)(gbase) + (voff)[_i]), (PG8_LAS unsigned*)(lds + (bufoff) + ldsw + _i * 8192), 16, 0, 0); } while (0)
#define PG8_LDA(dst, b, h) do { _Pragma("unroll") for (int m = 0; m < 4; ++m) _Pragma("unroll") for (int k = 0; k < 2; ++k) dst[m][k] = *(const PG8_LAS bf16x8*)(lds + PG8_SA(b, h) + aoff + m * 2048 + k * 1024); } while (0)
#define PG8_LDB(dst, b, h) do { _Pragma("unroll") for (int n = 0; n < 2; ++n) _Pragma("unroll") for (int k = 0; k < 2; ++k) dst[n][k] = *(const PG8_LAS bf16x8*)(lds + PG8_SB(b, h) + boff + n * 2048 + k * 1024); } while (0)
#define PG8_MMA(ai, bj, At, Bt) do { __builtin_amdgcn_s_setprio(1); _Pragma("unroll") for (int m = 0; m < 4; ++m) _Pragma("unroll") for (int n = 0; n < 2; ++n) _Pragma("unroll") for (int k = 0; k < 2; ++k) \
        acc[ai][bj][m][n] = __builtin_amdgcn_mfma_f32_16x16x32_bf16(Bt[n][k], At[m][k], acc[ai][bj][m][n], 0, 0, 0); __builtin_amdgcn_s_setprio(0); } while (0)
#define PG8_WAIT_V(n) asm volatile("s_waitcnt vmcnt(" #n ")" ::: "memory")
#define PG8_WAIT_L(n) asm volatile("s_waitcnt lgkmcnt(" #n ")" ::: "memory")
#define PG8_BAR __builtin_amdgcn_s_barrier()
#define PG8_SCHED __builtin_amdgcn_sched_barrier(0)
    Unit cur, nxt; int ui = 0;
    if (!S.next(0, cur)) return;
    f32x4 acc[2][2][4][2];
#pragma unroll
    for (int a = 0; a < 2; ++a)
#pragma unroll
        for (int b = 0; b < 2; ++b)
#pragma unroll
            for (int m = 0; m < 4; ++m)
#pragma unroll
                for (int n = 0; n < 2; ++n) acc[a][b][m][n] = (f32x4){0.f, 0.f, 0.f, 0.f};
    bf16x8 At[4][2], B0[2][2], B1[2][2];
    const char* cA = (const char*)g.A + (size_t)cur.pm * tstep; const char* cB = (const char*)g.Bt + (size_t)cur.pn * tstep;
    S.a_ready(cur);
    if constexpr (SP2) {
        PG8_STAGE(PG8_SB(0, 0), cB, voffB); PG8_STAGE(PG8_SB(0, 1), cB + hstep, voffB); PG8_STAGE(PG8_SA(0, 0), cA, voffA); PG8_STAGE(PG8_SA(0, 1), cA + hstep, voffA);
        if (wr == 1) PG8_BAR;
        PG8_WAIT_V(2); PG8_BAR;
        PG8_STAGE(PG8_SB(1, 0), cB + kstep, voffB); PG8_STAGE(PG8_SA(1, 0), cA + kstep, voffA); PG8_STAGE(PG8_SB(1, 1), cB + hstep + kstep, voffB);
        PG8_WAIT_V(6); PG8_BAR;
    } else {
        PG8_STAGE(PG8_SB(0, 0), cB, voffB); PG8_STAGE(PG8_SA(0, 0), cA, voffA); PG8_STAGE(PG8_SB(0, 1), cB + hstep, voffB); PG8_STAGE(PG8_SA(0, 1), cA + hstep, voffA);
        if (wr == 1) PG8_BAR;
        PG8_WAIT_V(4); PG8_BAR;
        PG8_STAGE(PG8_SB(1, 0), cB + kstep, voffB); PG8_STAGE(PG8_SA(1, 0), cA + kstep, voffA); PG8_STAGE(PG8_SB(1, 1), cB + hstep + kstep, voffB);
        PG8_WAIT_V(6); PG8_BAR;
    }
    for (;;) {
        const bool has_next = S.next(ui + 1, nxt);
        const char* nA = has_next ? (const char*)g.A + (size_t)nxt.pm * tstep : cA; const char* nB = has_next ? (const char*)g.Bt + (size_t)nxt.pn * tstep : cB;
        for (int t = 0; t < nt; t += 2) {
            const bool last = (t == nt - 2);
            const char* a1 = cA + (size_t)(t + 1) * kstep;
            const char* a2 = last ? nA : cA + (size_t)(t + 2) * kstep; const char* b2 = last ? nB : cB + (size_t)(t + 2) * kstep;
            const char* a3 = a2 + kstep; const char* b3 = b2 + kstep;
            if (last && has_next) S.a_ready(nxt);
            if constexpr (SP2) {
            PG8_LDB(B0, 0, 0); PG8_LDB(B1, 0, 1); PG8_SCHED; PG8_LDA(At, 0, 0); PG8_STAGE(PG8_SA(1, 1), a1 + hstep, voffA);
            PG8_WAIT_V(8); PG8_WAIT_L(0); PG8_BAR; PG8_MMA(0, 0, At, B0); PG8_MMA(0, 1, At, B1); PG8_BAR; PG8_SCHED;
            PG8_LDA(At, 0, 1); PG8_STAGE(PG8_SB(0, 0), b2, voffB); PG8_STAGE(PG8_SB(0, 1), b2 + hstep, voffB); PG8_STAGE(PG8_SA(0, 0), a2, voffA);
            PG8_WAIT_V(8); PG8_WAIT_L(0); PG8_BAR; PG8_MMA(1, 0, At, B0); PG8_MMA(1, 1, At, B1); PG8_BAR; PG8_SCHED;
            PG8_LDB(B0, 1, 0); PG8_LDB(B1, 1, 1); PG8_SCHED; PG8_LDA(At, 1, 0); PG8_STAGE(PG8_SA(0, 1), a2 + hstep, voffA);
            PG8_WAIT_V(8); PG8_WAIT_L(0); PG8_BAR; PG8_MMA(0, 0, At, B0); PG8_MMA(0, 1, At, B1); PG8_BAR; PG8_SCHED;
            PG8_LDA(At, 1, 1); PG8_STAGE(PG8_SB(1, 0), b3, voffB); PG8_STAGE(PG8_SB(1, 1), b3 + hstep, voffB); PG8_STAGE(PG8_SA(1, 0), a3, voffA);
            PG8_WAIT_V(8); PG8_WAIT_L(0); PG8_BAR; PG8_MMA(1, 0, At, B0); PG8_MMA(1, 1, At, B1); PG8_BAR; PG8_SCHED;
            } else {
            PG8_LDB(B0, 0, 0); PG8_SCHED; PG8_LDA(At, 0, 0); PG8_STAGE(PG8_SA(1, 1), a1 + hstep, voffA);
            PG8_WAIT_L(8); PG8_BAR; PG8_WAIT_L(0); PG8_MMA(0, 0, At, B0); PG8_BAR; PG8_SCHED;
            PG8_LDB(B1, 0, 1); PG8_STAGE(PG8_SB(0, 0), b2, voffB);
            PG8_BAR; PG8_WAIT_L(0); PG8_MMA(0, 1, At, B1); PG8_BAR;
            PG8_LDA(At, 0, 1); PG8_STAGE(PG8_SA(0, 0), a2, voffA);
            PG8_BAR; PG8_WAIT_L(0); PG8_MMA(1, 0, At, B0); PG8_BAR; PG8_SCHED;
            PG8_STAGE(PG8_SB(0, 1), b2 + hstep, voffB);
            PG8_WAIT_V(6); PG8_BAR; PG8_MMA(1, 1, At, B1); PG8_BAR;
            PG8_LDB(B0, 1, 0); PG8_SCHED; PG8_LDA(At, 1, 0); PG8_STAGE(PG8_SA(0, 1), a2 + hstep, voffA);
            PG8_WAIT_L(8); PG8_BAR; PG8_WAIT_L(0); PG8_MMA(0, 0, At, B0); PG8_BAR; PG8_SCHED;
            PG8_LDB(B1, 1, 1); PG8_STAGE(PG8_SB(1, 0), b3, voffB);
            PG8_BAR; PG8_WAIT_L(0); PG8_MMA(0, 1, At, B1); PG8_BAR;
            PG8_LDA(At, 1, 1); PG8_STAGE(PG8_SA(1, 0), a3, voffA);
            PG8_BAR; PG8_WAIT_L(0); PG8_MMA(1, 0, At, B0); PG8_BAR; PG8_SCHED;
            PG8_STAGE(PG8_SB(1, 1), b3 + hstep, voffB);
            PG8_WAIT_V(6); PG8_BAR; PG8_MMA(1, 1, At, B1); PG8_BAR;
            }
        }
        if constexpr (ALIGN_EPI) { if (wr == 0) PG8_BAR; }
        if constexpr (!Epi::AFTER_DRAIN) { E(acc, cur, wr, wc, fr, fq); S.done(cur); }
        if (!has_next) break;
#pragma unroll
        for (int a = 0; a < 2; ++a)
#pragma unroll
            for (int b = 0; b < 2; ++b)
#pragma unroll
                for (int m = 0; m < 4; ++m)
#pragma unroll
                    for (int n = 0; n < 2; ++n) acc[a][b][m][n] = (f32x4){0.f, 0.f, 0.f, 0.f};
        cur = nxt; cA = nA; cB = nB; ++ui;
        if constexpr (ALIGN_EPI) { if (wr == 1) PG8_BAR; }
    }
    PG8_WAIT_V(0);
    if constexpr (!ALIGN_EPI) { if (wr == 0) PG8_BAR; }
    PG8_BAR;
    if constexpr (Epi::AFTER_DRAIN) { E.fused(acc, cur, wr, wc, fr, fq, lds, wid, lane); S.done(cur); }
#undef PG8_SA
#undef PG8_SB
#undef PG8_STAGE
#undef PG8_LDA
#undef PG8_LDB
#undef PG8_MMA
#undef PG8_WAIT_V
#undef PG8_WAIT_L
#undef PG8_BAR
#undef PG8_SCHED
}
}
constexpr int NWAVES = 8;
#ifndef MK_N_LAUNCHES
#define MK_N_LAUNCHES 1
#endif
constexpr int NPH = 11;
constexpr int N_LAUNCHES = MK_N_LAUNCHES;
static_assert(N_LAUNCHES == 1 || N_LAUNCHES == NPH, "MK_N_LAUNCHES is 1 or 11");

constexpr int BATCH = 4, SEQ = 4096, D = 4096, M = BATCH * SEQ;
constexpr int ATT_W = 3072, IN_COLS = 25600, FFN = 12288, PLE = 256;
constexpr size_t MiB = 1u << 20;
constexpr size_t WS_CTL = 0, CTL_ZERO_BYTES = 1 * MiB;
constexpr size_t WS_LSE = 2 * MiB;
constexpr size_t WS_PB = 4 * MiB;
constexpr size_t WS_WUP = 16 * MiB, WS_WDOWN = 208 * MiB, WS_WPG = 304 * MiB, WS_WATT = 336 * MiB, WS_WLRU = 360 * MiB, WS_WOUT = 392 * MiB;
constexpr size_t WS_WPP = 424 * MiB, WS_WRG = 426 * MiB, WS_WIG = 428 * MiB;
constexpr size_t WS_WIN = 432 * MiB, WS_XB = 632 * MiB;
constexpr size_t WS_Q = 760 * MiB, WS_K = 856 * MiB, WS_V = 952 * MiB, WS_XR = 1048 * MiB, WS_YG = 1176 * MiB, WS_GA = 1304 * MiB, WS_GR = 1432 * MiB;
constexpr size_t WS_O = 432 * MiB, WS_LRU = 528 * MiB;
constexpr size_t WS_T = 760 * MiB, WS_MRG = 1048 * MiB;
constexpr size_t WS_X1 = 432 * MiB, WS_X1B = 1176 * MiB;
constexpr size_t WS_ACT = 688 * MiB;
constexpr size_t WS_X2B = 1304 * MiB, WS_ERAW = 1432 * MiB;
constexpr size_t WS_HALO = 1560 * MiB, WS_HEAD = 1572 * MiB, WS_END = 1584 * MiB;
constexpr int CW_BAR = 4096;
constexpr size_t CTL_RSS1 = 256 * 1024, CTL_RSS2 = 320 * 1024, CTL_RSS3 = 384 * 1024, CTL_RSSE = 448 * 1024, CTL_RSS0 = 512 * 1024;
constexpr int RING_OFF = 0, MISC_OFF = 135168, XH_OFF = 139264, LDS_BYTES = 147456;

#define GAS __attribute__((address_space(1)))
#define LAS __attribute__((address_space(3)))
typedef unsigned short bf16;
typedef unsigned v4u __attribute__((ext_vector_type(4)));
typedef float f32x4 __attribute__((ext_vector_type(4)));
typedef short bf16x8 __attribute__((ext_vector_type(8)));
typedef GAS unsigned gu32;
typedef GAS unsigned long long gu64;
#define RLX_AGENT __ATOMIC_RELAXED, __HIP_MEMORY_SCOPE_AGENT
#define LDS_WAIT() asm volatile("s_waitcnt lgkmcnt(0)" ::: "memory")
#define VM_WAIT() asm volatile("s_waitcnt vmcnt(0)" ::: "memory")
__device__ __forceinline__ unsigned long long rt() { return __builtin_amdgcn_s_memrealtime(); }
__device__ __forceinline__ unsigned f2bf(float f) { unsigned u = __builtin_bit_cast(unsigned, f); return (u + 0x7fffu + ((u >> 16) & 1u)) >> 16; }
__device__ __forceinline__ unsigned pk2(float lo, float hi) { return f2bf(lo) | (f2bf(hi) << 16); }

#define XB_TMO      128
#define XB_XCNT(j)  (256  + 64 * (j))
#define XB_XSUB(j)  (1280 + 64 * (j))
#define XB_XGEN(j)  (2304 + 64 * (j))
#define XB_TOP      3328
#define XB_TOPGEN   3392
#define XCD_BAR_WORDS 3456
#define XB_SPIN_CAP (1u << 18)

__device__ __forceinline__ unsigned xb_ld(unsigned* p)              { return __hip_atomic_load(p, __ATOMIC_RELAXED, __HIP_MEMORY_SCOPE_AGENT); }
__device__ __forceinline__ unsigned xb_add(unsigned* p, unsigned v) { return __hip_atomic_fetch_add(p, v, __ATOMIC_RELAXED, __HIP_MEMORY_SCOPE_AGENT); }
__device__ __forceinline__ unsigned xb_xcc_id() { return (unsigned)__builtin_amdgcn_s_getreg((3 << 11) | 20) & 0xFu; }
#define XB_SPIN(cond, bar) do { unsigned _sp = 0; while (cond) { __builtin_amdgcn_s_sleep(1); \
    if ((++_sp & 255u) == 0u) { if (xb_ld(&(bar)[XB_TMO])) break; if (_sp > XB_SPIN_CAP) { atomicAdd(&(bar)[XB_TMO], 1u); break; } } } } while (0)

struct XcdBarrier {
    unsigned* bar; unsigned x;
    volatile LAS unsigned* st;
};

__device__ __forceinline__ XcdBarrier xcd_barrier_post(unsigned* bar, volatile LAS unsigned* st, const bool t0  ) {
    XcdBarrier b; b.bar = bar; b.x = xb_xcc_id(); b.st = st;
    if (t0) (void)xb_add(&bar[XB_XCNT(b.x)], 1u);
    return b;
}
__device__ __forceinline__ void xcd_barrier_complete(unsigned* bar, unsigned x, unsigned& nloc, unsigned& nx) {
    const unsigned G = gridDim.x * gridDim.y * gridDim.z;
    unsigned sum, cnt, mine, sp = 0u;
    for (;;) {
        sum = 0u; cnt = 0u; mine = 0u;
#pragma unroll
        for (unsigned j = 0; j < 16; ++j) { const unsigned c = xb_ld(&bar[XB_XCNT(j)]); sum += c; cnt += (c > 0u) ? 1u : 0u; mine = (j == x) ? c : mine; }
        if (sum == G) break;
        __builtin_amdgcn_s_sleep(1);
        if ((++sp & 255u) == 0u) { if (xb_ld(&bar[XB_TMO])) break; if (sp > XB_SPIN_CAP) { atomicAdd(&bar[XB_TMO], 1u); break; } }
    }
    nloc = mine > 0u ? mine : 1u; nx = cnt > 0u ? cnt : 1u;
}

__device__ __forceinline__ void xcd_barrier(const XcdBarrier& b, const bool t0) {
    asm volatile("s_waitcnt vmcnt(0)" ::: "memory");
    __syncthreads();
    if (t0) {
        unsigned* bar = b.bar;
        __builtin_amdgcn_s_waitcnt(0);
        unsigned nloc = b.st[0], nx = b.st[1];
        if (nloc == 0u) { xcd_barrier_complete(bar, b.x, nloc, nx); b.st[0] = nloc; b.st[1] = nx; }
        const unsigned old = xb_add(&bar[XB_XSUB(b.x)], 1u);
        const unsigned gen = old / nloc;
        if (old + 1u == (gen + 1u) * nloc) {
            __builtin_amdgcn_fence(__ATOMIC_RELEASE, "agent");
            asm volatile("s_waitcnt vmcnt(0)" ::: "memory");
            const unsigned og = xb_add(&bar[XB_TOP], 1u);
            const unsigned tg = og / nx;
            if (og + 1u == (tg + 1u) * nx) xb_add(&bar[XB_TOPGEN], 1u);
            else XB_SPIN(xb_ld(&bar[XB_TOPGEN]) == tg, bar);
            __builtin_amdgcn_fence(__ATOMIC_ACQUIRE, "agent");
            xb_add(&bar[XB_XGEN(b.x)], 1u);
            asm volatile("s_waitcnt vmcnt(0)" ::: "memory");
        } else {
            XB_SPIN(xb_ld(&bar[XB_XGEN(b.x)]) == gen, bar);
            __builtin_amdgcn_fence(__ATOMIC_ACQUIRE, "agent");
            asm volatile("s_waitcnt vmcnt(0)" ::: "memory");
        }
    }
    __syncthreads();
}

struct Frame {
    LAS unsigned char* lds; volatile LAS unsigned* MISC; gu32* ctl;
    int vcu, G, wave;
    const float* const* in; float* out; unsigned char* ws;
};
__device__ __forceinline__ int opaque_lane() { int l = (int)__builtin_amdgcn_mbcnt_hi(~0u, __builtin_amdgcn_mbcnt_lo(~0u, 0u)); asm volatile("" : "+v"(l)); return l; }
#define THREAD_COORDS() const int lane = opaque_lane(), wave = F.wave, tid = wave * 64 + lane; (void)tid
__device__ __forceinline__ float wave_sum(float v) {
#pragma unroll
    for (int o = 1; o < 64; o <<= 1) v += __shfl_xor(v, o);
    return v;
}
__device__ __forceinline__ unsigned pkbf(float lo, float hi) { return pg8::cvt_pk_bf16(lo, hi); }
using pg8::bf_lo; using pg8::bf_hi; using pg8::sigmoid_f; using pg8::gelu_tanh_f; using pg8::rstd_of;
typedef unsigned u32x2 __attribute__((ext_vector_type(2)));

__device__ __forceinline__ void p0_transpose_item(const float* W, int K, int N, bf16* WT, int nrow0, int scol0, int k0, const float* g, LAS float* scr, int lane) {
#pragma unroll 8
    for (int i = 0; i < 32; ++i) { const int kk = 2 * i + (lane >> 5); float v = W[(size_t)(k0 + kk) * N + scol0 + (lane & 31)]; if (g) v *= g[k0 + kk]; scr[kk * 33 + (lane & 31)] = v; }
    LDS_WAIT(); asm volatile("" ::: "memory");
    const int c = lane & 7;
#pragma unroll
    for (int j = 0; j < 4; ++j) { const int n = (lane >> 3) + 8 * j; const LAS float* s = scr + (8 * c) * 33 + n;
        v4u o; o.x = pkbf(s[0 * 33], s[1 * 33]); o.y = pkbf(s[2 * 33], s[3 * 33]); o.z = pkbf(s[4 * 33], s[5 * 33]); o.w = pkbf(s[6 * 33], s[7 * 33]);
        *(GAS v4u*)(WT + (size_t)(nrow0 + n) * K + k0 + 8 * c) = o; }
    LDS_WAIT(); asm volatile("" ::: "memory");
}
struct WSpec { const float* W; bf16* WT; const float* g; int K, N, Nd, mode, nmat; };
__device__ __forceinline__ void p0_prologue(Frame& F) {
    THREAD_COORDS();
    LAS float* scr = (LAS float*)(F.lds + RING_OFF + wave * 16384);
    const int gw = F.vcu * NWAVES + wave, NGW = F.G * NWAVES;
    unsigned char* ws = F.ws;
    const WSpec specs[10] = {
        {F.in[3],  (bf16*)(ws + WS_WIN),   F.in[2],  4096, IN_COLS, IN_COLS, 0, 1},
        {F.in[15], (bf16*)(ws + WS_WUP),   F.in[14], 4096, 2 * FFN, 2 * FFN, 1, 1},
        {F.in[18], (bf16*)(ws + WS_WDOWN), nullptr,  FFN,  4096, 4096, 0, 1},
        {F.in[11], (bf16*)(ws + WS_WATT),  nullptr,  ATT_W, 4096, 4096, 0, 1},
        {F.in[12], (bf16*)(ws + WS_WLRU),  nullptr,  4096, 4096, 4096, 0, 1},
        {F.in[13], (bf16*)(ws + WS_WOUT),  nullptr,  4096, 4096, 4096, 0, 1},
        {F.in[22], (bf16*)(ws + WS_WPG),   F.in[21], 4096, 4096, 4096, 0, 1},
        {F.in[19], (bf16*)(ws + WS_WPP),   nullptr,  PLE,  4096, 4096, 0, 1},
        {F.in[6],  (bf16*)(ws + WS_WRG),   nullptr,  256,  256, 256, 0, 16},
        {F.in[8],  (bf16*)(ws + WS_WIG),   nullptr,  256,  256, 256, 0, 16}};
    int base = 0;
#pragma unroll
    for (int s = 0; s < 10; ++s) {
        const WSpec sp = specs[s]; const int nblk = sp.Nd / 32, kblk = sp.K / 64, per = nblk * kblk, total = per * sp.nmat;
        int it = gw - (base % NGW); if (it < 0) it += NGW;
        for (; it < total; it += NGW) {
            const int mt = it / per, r = it % per, kb = r / nblk, nb = r % nblk;
            int scol0 = 32 * nb;
            if (sp.mode == 1) { const int pn = nb >> 3, c0 = (nb & 7) * 32; scol0 = c0 < 128 ? pn * 128 + c0 : FFN + pn * 128 + (c0 - 128); }
            p0_transpose_item(sp.W + (size_t)mt * sp.K * sp.N, sp.K, sp.N, sp.WT + (size_t)mt * sp.K * sp.Nd, 32 * nb, scol0, 64 * kb, sp.g, scr, lane);
        }
        base += total;
    }
    const float* x = F.in[0]; bf16* xb = (bf16*)(ws + WS_XB); float* rss0 = (float*)(ws + WS_CTL + CTL_RSS0);
    for (int m = gw; m < M; m += NGW) {
        const GAS f32x4* xr = (const GAS f32x4*)(x + (size_t)m * D) + lane; GAS u32x2* o8 = (GAS u32x2*)(xb + (size_t)m * D) + lane; float s = 0.f;
#pragma unroll
        for (int j = 0; j < 16; ++j) { const f32x4 v = xr[64 * j]; s += (v.x * v.x + v.y * v.y) + (v.z * v.z + v.w * v.w); u32x2 w; w.x = pkbf(v.x, v.y); w.y = pkbf(v.z, v.w); o8[64 * j] = w; }
        s = wave_sum(s); if (lane == 0) rss0[m] = s;
    }
    const float* p = F.in[1]; bf16* pb = (bf16*)(ws + WS_PB);
    for (size_t i = (size_t)(F.vcu * 512 + tid); i < (size_t)M * PLE / 4; i += (size_t)F.G * 512) { const f32x4 v = ((const GAS f32x4*)p)[i]; u32x2 w; w.x = pkbf(v.x, v.y); w.y = pkbf(v.z, v.w); ((GAS u32x2*)pb)[i] = w; }
}

constexpr int AT_VS = 272, AT_PS = 168, AT_P_OFF = 128 * AT_VS * 2;
static_assert(AT_P_OFF + NWAVES * 16 * AT_PS * 2 <= 131072, "attention LDS");
__device__ __forceinline__ void attn_unit(Frame& F, int au) {
    const int g = au >> 10, rem = au & 1023, dil = g == 0 ? 1 : (g == 1 ? 4 : 16), nb = 32 / dil;
    const int b = rem >> 8, h = (rem >> 5) & 7, r = (rem & 31) / nb, c = (rem & 31) % nb;
    const int cb = g * 1024 + h * 128; const size_t mb = (size_t)b * SEQ;
    const bf16* Qb = (const bf16*)(F.ws + WS_Q); const bf16* Kb = (const bf16*)(F.ws + WS_K); const bf16* Vb = (const bf16*)(F.ws + WS_V);
    bf16* Ob = (bf16*)(F.ws + WS_O); float* LSE = (float*)(F.ws + WS_LSE);
    THREAD_COORDS();
    LAS bf16* Vt = (LAS bf16*)(F.lds); LAS bf16* Pw = (LAS bf16*)(F.lds + AT_P_OFF + wave * (16 * AT_PS * 2));
    const int w = wave, q = lane & 15, kg = lane >> 4;
#pragma unroll
    for (int it = 0; it < 8; ++it) { const int x = tid + 512 * it, j = x & 255, dch = x >> 8; const int lk = (c - 1) * 128 + j;
        v4u v = {0u, 0u, 0u, 0u}; if (lk >= 0) v = *(const GAS v4u*)(Vb + (mb + (size_t)lk * dil + r) * ATT_W + cb + 8 * dch);
        LAS bf16* d0 = Vt + (8 * dch) * AT_VS + j;
        d0[0 * AT_VS] = (bf16)(v.x & 0xffffu); d0[1 * AT_VS] = (bf16)(v.x >> 16); d0[2 * AT_VS] = (bf16)(v.y & 0xffffu); d0[3 * AT_VS] = (bf16)(v.y >> 16);
        d0[4 * AT_VS] = (bf16)(v.z & 0xffffu); d0[5 * AT_VS] = (bf16)(v.z >> 16); d0[6 * AT_VS] = (bf16)(v.w & 0xffffu); d0[7 * AT_VS] = (bf16)(v.w >> 16); }
#pragma unroll
    for (int it = 0; it < 2; ++it) { const int x = tid + 512 * it; ((LAS unsigned*)(Vt + (x >> 3) * AT_VS + 256))[x & 7] = 0u; }
    const int lq = c * 128 + 16 * w + q; const size_t mq = mb + (size_t)lq * dil + r;
    bf16x8 qf[4];
#pragma unroll
    for (int ks = 0; ks < 4; ++ks) qf[ks] = *(const GAS bf16x8*)(Qb + mq * ATT_W + cb + 32 * ks + 8 * kg);
    f32x4 s[9];
#pragma unroll
    for (int kt = 0; kt < 9; ++kt) { int lk = (c - 1) * 128 + 16 * w + 16 * kt + q; lk = lk < 0 ? 0 : lk; const bf16* kp = Kb + (mb + (size_t)lk * dil + r) * ATT_W + cb + 8 * kg;
        f32x4 a = {0.f, 0.f, 0.f, 0.f};
#pragma unroll
        for (int ks = 0; ks < 4; ++ks) { const bf16x8 kf = *(const GAS bf16x8*)(kp + 32 * ks); a = __builtin_amdgcn_mfma_f32_16x16x32_bf16(kf, qf[ks], a, 0, 0, 0); }
        s[kt] = a; }
    float mx = -1e30f;
#pragma unroll
    for (int kt = 0; kt < 9; ++kt)
#pragma unroll
        for (int e = 0; e < 4; ++e) { const int jmi = 16 * kt + 4 * kg + e - q; const int lk = (c - 1) * 128 + 16 * w + 16 * kt + 4 * kg + e;
            const bool ok = (jmi >= 0) && (jmi <= 128) && (lk >= 0); const float v = ok ? s[kt][e] * 0.08838834764831845f : -1e30f; s[kt][e] = v; mx = fmaxf(mx, v); }
    mx = fmaxf(mx, __shfl_xor(mx, 16)); mx = fmaxf(mx, __shfl_xor(mx, 32));
    float den = 0.f;
#pragma unroll
    for (int kt = 0; kt < 9; ++kt) {
#pragma unroll
        for (int e = 0; e < 4; ++e) { const float p = __builtin_amdgcn_exp2f((s[kt][e] - mx) * 1.4426950408889634f); s[kt][e] = p; den += p; }
        u32x2 pw; pw.x = pkbf(s[kt][0], s[kt][1]); pw.y = pkbf(s[kt][2], s[kt][3]); *(LAS u32x2*)(Pw + q * AT_PS + 16 * kt + 4 * kg) = pw; }
    { u32x2 z; z.x = 0u; z.y = 0u; *(LAS u32x2*)(Pw + (lane >> 2) * AT_PS + 144 + 4 * (lane & 3)) = z; }
    den += __shfl_xor(den, 16); den += __shfl_xor(den, 32);
    if (kg == 0) LSE[mq * 24 + g * 8 + h] = mx + __logf(den);
    const float inv = 1.0f / den;
    LDS_WAIT(); __syncthreads();
    bf16x8 pf[5];
#pragma unroll
    for (int ks = 0; ks < 5; ++ks) pf[ks] = *(const LAS bf16x8*)(Pw + q * AT_PS + 32 * ks + 8 * kg);
#pragma unroll
    for (int dt = 0; dt < 8; ++dt) { f32x4 a = {0.f, 0.f, 0.f, 0.f};
#pragma unroll
        for (int ks = 0; ks < 5; ++ks) { const bf16x8 vf = *(const LAS bf16x8*)(Vt + (16 * dt + q) * AT_VS + 16 * w + 32 * ks + 8 * kg); a = __builtin_amdgcn_mfma_f32_16x16x32_bf16(vf, pf[ks], a, 0, 0, 0); }
        u32x2 o; o.x = pkbf(a[0] * inv, a[1] * inv); o.y = pkbf(a[2] * inv, a[3] * inv);
        *(GAS u32x2*)(Ob + mq * ATT_W + cb + 16 * dt + 4 * kg) = o; }
    LDS_WAIT(); __syncthreads();
}

constexpr int LR_AS = 264, LR_LA_OFF = 128 * LR_AS * 2, LR_LB_OFF = LR_LA_OFF + 128 * 64 * 4;
static_assert(LR_LB_OFF + 128 * 64 * 4 <= MISC_OFF, "LRU LDS");
__device__ __forceinline__ void lru_unit(Frame& F, int u) {
    const int b = u >> 6, n = (u >> 2) & 15, jq = u & 3, chb = n * 256, ch0 = chb + jq * 64; const size_t mb = (size_t)b * SEQ;
    THREAD_COORDS();
    const int w = wave, jt = w & 3, th = w >> 2, q = lane & 15, kg = lane >> 4;
    const bf16* XR = (const bf16*)(F.ws + WS_XR); const bf16* YG = (const bf16*)(F.ws + WS_YG); bf16* LRU = (bf16*)(F.ws + WS_LRU);
    const bf16* Wrg = (const bf16*)(F.ws + WS_WRG); const bf16* Wig = (const bf16*)(F.ws + WS_WIG);
    LAS bf16* Aimg = (LAS bf16*)(F.lds); LAS float* LA = (LAS float*)(F.lds + LR_LA_OFF); LAS float* LB = (LAS float*)(F.lds + LR_LB_OFF);
    const int jrow = jq * 64 + jt * 16 + q;
    bf16x8 brf[8], bif[8];
#pragma unroll
    for (int ks = 0; ks < 8; ++ks) { brf[ks] = *(const GAS bf16x8*)(Wrg + ((size_t)n * 256 + jrow) * 256 + 32 * ks + 8 * kg); bif[ks] = *(const GAS bf16x8*)(Wig + ((size_t)n * 256 + jrow) * 256 + 32 * ks + 8 * kg); }
    const float biasr = F.in[7][chb + jrow], biasi = F.in[9][chb + jrow], sp = log1pf(expf(-F.in[10][chb + jrow]));
    const int oct = tid & 31;
    float cw[4][8], cbs[8];
#pragma unroll
    for (int e = 0; e < 8; ++e) { cbs[e] = F.in[5][chb + 8 * oct + e];
#pragma unroll
        for (int k = 0; k < 4; ++k) cw[k][e] = F.in[4][k * 4096 + chb + 8 * oct + e]; }
    float hc = 0.f;
    for (int ci = 0; ci < SEQ / 128; ++ci) {
        const int t0 = ci * 128;
#pragma unroll 2
        for (int it = 0; it < 8; ++it) { const int tr = (tid >> 5) + 16 * it, tg = t0 + tr; float a8[8];
#pragma unroll
            for (int e = 0; e < 8; ++e) a8[e] = cbs[e];
#pragma unroll
            for (int k = 0; k < 4; ++k) { const int tt = tg - 3 + k; if (tt >= 0) { const v4u xv = *(const GAS v4u*)(XR + (mb + tt) * D + chb + 8 * oct);
                a8[0] += cw[k][0] * bf_lo(xv.x); a8[1] += cw[k][1] * bf_hi(xv.x); a8[2] += cw[k][2] * bf_lo(xv.y); a8[3] += cw[k][3] * bf_hi(xv.y);
                a8[4] += cw[k][4] * bf_lo(xv.z); a8[5] += cw[k][5] * bf_hi(xv.z); a8[6] += cw[k][6] * bf_lo(xv.w); a8[7] += cw[k][7] * bf_hi(xv.w); } }
            v4u o; o.x = pkbf(a8[0], a8[1]); o.y = pkbf(a8[2], a8[3]); o.z = pkbf(a8[4], a8[5]); o.w = pkbf(a8[6], a8[7]);
            *(LAS v4u*)(Aimg + tr * LR_AS + 8 * oct) = o; }
        LDS_WAIT(); __syncthreads();
#pragma unroll
        for (int rt = 0; rt < 4; ++rt) { f32x4 ar = {0.f, 0.f, 0.f, 0.f}, ai = {0.f, 0.f, 0.f, 0.f};
#pragma unroll
            for (int ks = 0; ks < 8; ++ks) { const bf16x8 af = *(const LAS bf16x8*)(Aimg + (th * 64 + rt * 16 + q) * LR_AS + 32 * ks + 8 * kg);
                ar = __builtin_amdgcn_mfma_f32_16x16x32_bf16(af, brf[ks], ar, 0, 0, 0); ai = __builtin_amdgcn_mfma_f32_16x16x32_bf16(af, bif[ks], ai, 0, 0, 0); }
#pragma unroll
            for (int e = 0; e < 4; ++e) { const int t = th * 64 + rt * 16 + 4 * kg + e, jl = jt * 16 + q;
                const float xcv = __uint_as_float(((unsigned)Aimg[t * LR_AS + jq * 64 + jl]) << 16);
                const float rr = sigmoid_f(ar[e] + biasr), ii = sigmoid_f(ai[e] + biasi), la = -8.0f * rr * sp;
                LA[t * 64 + jl] = __expf(la); LB[t * 64 + jl] = sqrtf(-expm1f(2.0f * la)) * ii * xcv; } }
        LDS_WAIT(); __syncthreads();
        if (w == 0) {
#pragma unroll 8
            for (int t = 0; t < 128; ++t) { hc = LA[t * 64 + lane] * hc + LB[t * 64 + lane]; LB[t * 64 + lane] = hc; }
        }
        LDS_WAIT(); __syncthreads();
#pragma unroll
        for (int it = 0; it < 2; ++it) { const int x = tid + 512 * it, t = x >> 3, oc = x & 7; const size_t go = (mb + t0 + t) * D + ch0 + 8 * oc;
            const f32x4 h0 = *(const LAS f32x4*)(LB + t * 64 + 8 * oc), h1 = *(const LAS f32x4*)(LB + t * 64 + 8 * oc + 4); const v4u yv = *(const GAS v4u*)(YG + go);
            v4u o; o.x = pkbf(h0[0] * bf_lo(yv.x), h0[1] * bf_hi(yv.x)); o.y = pkbf(h0[2] * bf_lo(yv.y), h0[3] * bf_hi(yv.y));
            o.z = pkbf(h1[0] * bf_lo(yv.z), h1[1] * bf_hi(yv.z)); o.w = pkbf(h1[2] * bf_lo(yv.w), h1[3] * bf_hi(yv.w));
            *(GAS v4u*)(LRU + go) = o; }
    }
    LDS_WAIT(); __syncthreads();
}

__device__ __forceinline__ void combine_phase(Frame& F) {
    THREAD_COORDS();
    bf16* Ob = (bf16*)(F.ws + WS_O); const float* LSE = (const float*)(F.ws + WS_LSE);
    for (size_t i = (size_t)(F.vcu * 512 + tid); i < (size_t)M * (ATT_W / 8); i += (size_t)F.G * 512) {
        const size_t m = i / (ATT_W / 8); const int ch = (int)(i % (ATT_W / 8)), g = ch >> 7, h = (ch & 127) >> 4;
        const float l0 = LSE[m * 24 + h], l1 = LSE[m * 24 + 8 + h], l2 = LSE[m * 24 + 16 + h], mx = fmaxf(l0, fmaxf(l1, l2));
        const float e0 = __expf(l0 - mx), e1 = __expf(l1 - mx), e2 = __expf(l2 - mx), wgt = (g == 0 ? e0 : (g == 1 ? e1 : e2)) / (e0 + e1 + e2);
        GAS v4u* p = (GAS v4u*)Ob + i; const v4u v = *p; v4u o;
        o.x = pkbf(bf_lo(v.x) * wgt, bf_hi(v.x) * wgt); o.y = pkbf(bf_lo(v.y) * wgt, bf_hi(v.y) * wgt); o.z = pkbf(bf_lo(v.z) * wgt, bf_hi(v.z) * wgt); o.w = pkbf(bf_lo(v.w) * wgt, bf_hi(v.w) * wgt);
        *p = o; }
}
__device__ __forceinline__ void fixup_phase(Frame& F) {
    const float* HALO = (const float*)(F.ws + WS_HALO); const float* HEAD = (const float*)(F.ws + WS_HEAD); bf16* ACT = (bf16*)(F.ws + WS_ACT);
    const float* cw = F.in[16]; const float* cb = F.in[17];
    THREAD_COORDS();
    const int total = 64 * 2 * FFN;
    for (int i = F.vcu * 512 + tid; i < total; i += F.G * 512) {
        const int G = i % FFN, rr = (i / FFN) & 1, pm = i / (2 * FFN); if ((pm & 15) == 0) continue;
        const int pn = G >> 7, gi = G & 127, cg = pn * 256 + gi, cv = cg + 128;
        const float* hp = HALO + (size_t)(pm - 1) * 2 * 24576; const float* hd = HEAD + (size_t)pm * 2 * 24576;
        float ug[4], uv[4];
        ug[0] = hp[cg]; ug[1] = hp[24576 + cg]; ug[2] = hd[cg]; ug[3] = hd[24576 + cg];
        uv[0] = hp[cv]; uv[1] = hp[24576 + cv]; uv[2] = hd[cv]; uv[3] = hd[24576 + cv];
        const float yg = cw[G] * ug[rr] + cw[24576 + G] * ug[rr + 1] + cw[2 * 24576 + G] * ug[rr + 2] + cb[G];
        const float yv = cw[FFN + G] * uv[rr] + cw[24576 + FFN + G] * uv[rr + 1] + cw[2 * 24576 + FFN + G] * uv[rr + 2] + cb[FFN + G];
        const float o = gelu_tanh_f(yg) * yv;
        ACT[(size_t)(pm * 256 + rr) * FFN + G] = (bf16)(pkbf(o, 0.f) & 0xffffu);
    }
}
__device__ __forceinline__ void final_phase(Frame& F) {
    THREAD_COORDS();
    const int gw = F.vcu * NWAVES + wave, NGW = F.G * NWAVES; const float* rss3 = (const float*)(F.ws + WS_CTL + CTL_RSS3); const GAS f32x4* gf = (const GAS f32x4*)F.in[23] + lane;
    for (int m = gw; m < M; m += NGW) { const float rs = rstd_of(rss3[m]); GAS f32x4* o = (GAS f32x4*)(F.out + (size_t)m * D) + lane;
#pragma unroll
        for (int j = 0; j < 16; ++j) { const f32x4 v = o[64 * j], g = gf[64 * j]; o[64 * j] = v * rs * g; } }
}

struct Args { const float* in[24]; float* out; unsigned char* ws; int ph_lo, ph_hi, li, pad; };
static_assert(WS_K - WS_Q == 96 * MiB && WS_V - WS_K == 96 * MiB && WS_YG - WS_XR == 128 * MiB && WS_GA - WS_YG == 128 * MiB && WS_GR - WS_GA == 128 * MiB, "EpiProj strides");
__global__ void __launch_bounds__(NWAVES * 64, 2) fwd_kernel(const Args args) {
    extern __shared__ __attribute__((aligned(16))) unsigned char lds[];
    Frame F;
    F.lds = (LAS unsigned char*)lds; F.MISC = (volatile LAS unsigned*)(F.lds + MISC_OFF);
    F.wave = __builtin_amdgcn_readfirstlane((int)threadIdx.x >> 6);
    F.G = gridDim.x; { const int bx = blockIdx.x; F.vcu = (F.G % 8 == 0) ? (bx % 8) * (F.G / 8) + bx / 8 : bx; }
    F.ws = args.ws; F.ctl = (gu32*)(args.ws + WS_CTL); F.out = args.out;
    F.in = args.in;
    for (int u = (int)threadIdx.x; u < 128; u += NWAVES * 64) ((LAS unsigned*)(F.lds + MISC_OFF))[u] = 0u;
    __syncthreads();
    XcdBarrier bar; bar.bar = (unsigned*)(F.ctl + CW_BAR); bar.x = 0; bar.st = nullptr;
    if (N_LAUNCHES == 1) bar = xcd_barrier_post((unsigned*)(F.ctl + CW_BAR), F.MISC + 8, threadIdx.x == 0);
#define GRID_BAR() do { if (N_LAUNCHES == 1) xcd_barrier(bar, F.wave == 0 && opaque_lane() == 0); } while (0)
    const int lo = args.ph_lo, hi = args.ph_hi;
#define IN(k) (lo <= (k) && (k) < hi)
#define BOTH(k) (IN(k) && IN((k) + 1))
    unsigned char* ws = args.ws;
    float* rss0 = (float*)(ws + WS_CTL + CTL_RSS0); float* rss1 = (float*)(ws + WS_CTL + CTL_RSS1); float* rss2 = (float*)(ws + WS_CTL + CTL_RSS2);
    float* rss3 = (float*)(ws + WS_CTL + CTL_RSS3); float* rsse = (float*)(ws + WS_CTL + CTL_RSSE);
    const int c = (int)blockIdx.x;

    if (IN(0)) { p0_prologue(F); if (BOTH(0)) GRID_BAR(); }
    if (IN(1)) {
        pg8::Gemm g{(const bf16*)(ws + WS_XB), (const bf16*)(ws + WS_WIN), M, IN_COLS, D}; pg8::StaticOrder S; S.init(M, IN_COLS, F.G, c);
        pg8::EpiProj E{(bf16*)(ws + WS_Q), (bf16*)(ws + WS_XR), rss0};
        pg8::gemm_phase<pg8::EpiProj, pg8::StaticOrder, true, true>(F.lds + RING_OFF, g, S, E, F.wave);
        if (BOTH(1)) GRID_BAR();
    }
    if (IN(2)) {
        if (F.vcu < 256) lru_unit(F, F.vcu);
        const int per = (3072 + F.G - 1) / F.G;
        for (int i = 0; i < per; ++i) { const int au = F.vcu * per + i; if (au < 3072) attn_unit(F, au); }
        for (int u = F.G + F.vcu; u < 256; u += F.G) lru_unit(F, u);
        if (BOTH(2)) GRID_BAR();
    }
    if (IN(3)) { combine_phase(F); if (BOTH(3)) GRID_BAR(); }
    if (IN(4)) {
        { pg8::Gemm g{(const bf16*)(ws + WS_O), (const bf16*)(ws + WS_WATT), M, D, ATT_W}; pg8::StaticOrder S; S.init(M, D, F.G, c);
          pg8::EpiGateT E{(const bf16*)(ws + WS_GA), (float*)(ws + WS_T)};
          pg8::gemm_phase<pg8::EpiGateT, pg8::StaticOrder, true, true>(F.lds + RING_OFF, g, S, E, F.wave); }
        { pg8::Gemm g{(const bf16*)(ws + WS_LRU), (const bf16*)(ws + WS_WLRU), M, D, D}; pg8::StaticOrder S; S.init(M, D, F.G, c);
          pg8::EpiMerge E{(const bf16*)(ws + WS_GR), (const float*)(ws + WS_T), (bf16*)(ws + WS_MRG)};
          pg8::gemm_phase<pg8::EpiMerge, pg8::StaticOrder, true, true>(F.lds + RING_OFF, g, S, E, F.wave); }
        if (BOTH(4)) GRID_BAR();
    }
    if (IN(5)) {
        { pg8::Gemm g{(const bf16*)(ws + WS_MRG), (const bf16*)(ws + WS_WOUT), M, D, D}; pg8::StaticOrder S; S.init(M, D, F.G, c);
          pg8::EpiResid E{F.in[0], (float*)(ws + WS_X1), (bf16*)(ws + WS_X1B), rss1};
          pg8::gemm_phase<pg8::EpiResid, pg8::StaticOrder, true, true>(F.lds + RING_OFF, g, S, E, F.wave); }
        { pg8::Gemm g{(const bf16*)(ws + WS_PB), (const bf16*)(ws + WS_WPP), M, D, PLE}; pg8::StaticOrder S; S.init(M, D, F.G, c);
          pg8::EpiBf16Stat E{(bf16*)(ws + WS_ERAW), rsse};
          pg8::gemm_phase<pg8::EpiBf16Stat, pg8::StaticOrder, true, true>(F.lds + RING_OFF, g, S, E, F.wave); }
        if (BOTH(5)) GRID_BAR();
    }
    if (IN(6)) {
        pg8::Gemm g{(const bf16*)(ws + WS_X1B), (const bf16*)(ws + WS_WUP), M, 2 * FFN, D}; pg8::StaticOrder S; S.init(M, 2 * FFN, F.G, c);
        pg8::EpiUpConv E{rss1, F.in[16], F.in[17], (bf16*)(ws + WS_ACT), (float*)(ws + WS_HALO), (float*)(ws + WS_HEAD), (LAS float*)(F.lds + XH_OFF)};
        pg8::gemm_phase<pg8::EpiUpConv, pg8::StaticOrder, true, true>(F.lds + RING_OFF, g, S, E, F.wave);
        if (BOTH(6)) GRID_BAR();
    }
    if (IN(7)) { fixup_phase(F); if (BOTH(7)) GRID_BAR(); }
    if (IN(8)) {
        pg8::Gemm g{(const bf16*)(ws + WS_ACT), (const bf16*)(ws + WS_WDOWN), M, D, FFN}; pg8::StaticOrder S; S.init(M, D, F.G, c);
        pg8::EpiResid E{(const float*)(ws + WS_X1), (float*)(ws + WS_X1), (bf16*)(ws + WS_X2B), rss2};
        pg8::gemm_phase<pg8::EpiResid, pg8::StaticOrder, true, true>(F.lds + RING_OFF, g, S, E, F.wave);
        if (BOTH(8)) GRID_BAR();
    }
    if (IN(9)) {
        pg8::Gemm g{(const bf16*)(ws + WS_X2B), (const bf16*)(ws + WS_WPG), M, D, D}; pg8::StaticOrder S; S.init(M, D, F.G, c);
        pg8::EpiPle E{(const float*)(ws + WS_X1), (const bf16*)(ws + WS_ERAW), rss2, rsse, F.in[20], F.out, rss3};
        pg8::gemm_phase<pg8::EpiPle, pg8::StaticOrder, true, true>(F.lds + RING_OFF, g, S, E, F.wave);
        if (BOTH(9)) GRID_BAR();
    }
    if (IN(10)) final_phase(F);
#undef IN
#undef BOTH
#undef GRID_BAR
}

extern "C" void kernel_launch(void* const* d_in, const int* in_sizes, int n_in, void* d_out, int out_size, void* d_ws, size_t ws_size, hipStream_t stream) {
    static int grid = 0;
    if (grid == 0) {
        if (n_in != 24 || in_sizes[0] != M * D || out_size != M * D || ws_size < WS_END) { fprintf(stderr, "kernel_launch: unexpected problem (n_in %d, in0 %d, out %d, ws %zu < %zu); nothing launched\n", n_in, n_in > 0 ? in_sizes[0] : -1, out_size, ws_size, (size_t)WS_END); grid = -1; return; }
        int dev = 0, cus = 0, per_cu = 0;
        if (hipGetDevice(&dev) != hipSuccess || hipDeviceGetAttribute(&cus, hipDeviceAttributeMultiprocessorCount, dev) != hipSuccess) { fprintf(stderr, "kernel_launch: device query failed\n"); grid = -1; return; }
        if (hipFuncSetAttribute((const void*)fwd_kernel, hipFuncAttributeMaxDynamicSharedMemorySize, LDS_BYTES) != hipSuccess) { fprintf(stderr, "kernel_launch: hipFuncSetAttribute failed\n"); grid = -1; return; }
        if (hipOccupancyMaxActiveBlocksPerMultiprocessor(&per_cu, (const void*)fwd_kernel, NWAVES * 64, LDS_BYTES) != hipSuccess || per_cu < 1) fprintf(stderr, "kernel_launch: note: occupancy query reports %d workgroups per CU\n", per_cu);
        (void)hipGetLastError();
        grid = cus;
    }
    if (grid < 0) return;
    if (hipMemsetAsync((char*)d_ws + WS_CTL, 0, CTL_ZERO_BYTES, stream) != hipSuccess) { fprintf(stderr, "kernel_launch: memset failed\n"); return; }
    Args a{};
    for (int i = 0; i < 24; ++i) a.in[i] = (const float*)d_in[i];
    a.out = (float*)d_out; a.ws = (unsigned char*)d_ws;
    for (int li = 0; li < N_LAUNCHES; ++li) {
        a.ph_lo = (N_LAUNCHES == 1) ? 0 : li; a.ph_hi = (N_LAUNCHES == 1) ? NPH : li + 1; a.li = li; a.pad = 0;
        hipLaunchKernelGGL(fwd_kernel, dim3(grid), dim3(NWAVES * 64), LDS_BYTES, stream, a);
        const hipError_t le = hipPeekAtLastError();
        if (le != hipSuccess) { fprintf(stderr, "kernel_launch: launch %d failed: %s\n", li, hipGetErrorName(le)); break; }
    }
}
```

```cpp
#include <hip/hip_runtime.h>
#include <cstdio>
#include <cstdint>
namespace pg8 {
#define PG8_LAS __attribute__((address_space(3)))
typedef unsigned short bf16_t;
typedef short bf16x8 __attribute__((ext_vector_type(8)));
typedef float f32x4 __attribute__((ext_vector_type(4)));
typedef unsigned u32x4 __attribute__((ext_vector_type(4)));
constexpr int BM = 256, BK = 64, HALF = 128, HTB = HALF * BK * 2  , STAGE_BYTES = 8 * HTB, NXCD = 8, WGM = 8;

__host__ __device__ __forceinline__ int lds_byte(int r, int c) { const int st = (r >> 4) * 2 + (c >> 5), rr = r & 15, cc = c & 31, ob = rr * 64 + cc * 2; return st * 1024 + (ob ^ (((ob >> 9) & 1) << 5)); }
__host__ __device__ __forceinline__ void stage_rc(int b, int& R, int& C) { const int st = b / 1024, sb = b % 1024, swz = sb ^ (((sb >> 9) & 1) << 5); R = (st >> 1) * 16 + swz / 64; C = (st & 1) * 32 + (swz % 64) / 2; }
__host__ __device__ __forceinline__ int perm32(int rho) { const int n = rho >> 4, i = rho & 15; return 8 * (i >> 2) + 4 * n + (i & 3); }

struct Unit { int pm, pn; };
struct Gemm { const bf16_t* A; const bf16_t* Bt; int M, N, K; };

struct StaticOrder {
    int nM, nN, nwg, G, c;
    __host__ __device__ void init(int M, int N, int G_, int c_) { nM = M / BM; nN = N / BM; nwg = nM * nN; G = G_; c = c_; }
    __host__ __device__ bool next(int i, Unit& u) const {
        const long L = (long)i * G + c; if (L >= nwg) return false;
        int wgid = (int)L; { const int q = nwg / NXCD, r = nwg % NXCD, xcd = wgid % NXCD, off = wgid / NXCD; wgid = (xcd < r ? xcd * (q + 1) : r * (q + 1) + (xcd - r) * q) + off; }
        const int nig = WGM * nN, gid = wgid / nig, fm = gid * WGM, gsz = (nM - fm) < WGM ? (nM - fm) : WGM;
        u.pm = fm + ((wgid % nig) % gsz); u.pn = (wgid % nig) / gsz; return true;
    }
    __device__ __forceinline__ void a_ready(const Unit&) const {}
    __device__ __forceinline__ void done(const Unit&) const {}
};

__device__ __forceinline__ unsigned cvt_pk_bf16(float lo, float hi) { unsigned r; asm volatile("v_cvt_pk_bf16_f32 %0, %1, %2" : "=v"(r) : "v"(lo), "v"(hi)); return r; }
typedef float f32x2 __attribute__((ext_vector_type(2)));
__device__ __forceinline__ float sigmoid_f(float v) { return __builtin_amdgcn_rcpf(1.0f + __builtin_amdgcn_exp2f(-1.4426950408889634f * v)); }
__device__ __forceinline__ float gelu_tanh_f(float v) { const float u = v * (1.0f + 0.044715f * v * v); return v * __builtin_amdgcn_rcpf(1.0f + __builtin_amdgcn_exp2f(-2.3022081984901087f * u)); }
__device__ __forceinline__ float bf_lo(unsigned w) { return __uint_as_float(w << 16); }
__device__ __forceinline__ float bf_hi(unsigned w) { return __uint_as_float(w & 0xffff0000u); }
typedef unsigned u32x2 __attribute__((ext_vector_type(2)));
constexpr float RMS_EPS = 1e-6f;
__device__ __forceinline__ float rstd_of(float ss) { return __builtin_amdgcn_rsqf(ss * (1.0f / 4096.0f) + RMS_EPS); }

struct EpiProj {
    static constexpr bool PERM = true, AFTER_DRAIN = false;
    bf16_t *Q, *XR; const float* rowss;
    __device__ __forceinline__ void operator()(f32x4 (&acc)[2][2][4][2], const Unit& u, int wr, int wc, int fr, int fq) const {
        asm volatile("" : "+v"(fr), "+v"(fq));
        int colt = u.pn * BM; bf16_t* base; int ldc, act;
        if (colt < 9216) { const int t = colt / 3072; base = Q + (size_t)t * (size_t)50331648; colt -= t * 3072; ldc = 3072; act = 0; }
        else { const int t = (colt - 9216) / 4096; base = XR + (size_t)t * (size_t)67108864; colt -= 9216 + t * 4096; ldc = 4096; act = t > 2 ? 2 : t; }
        const int row0 = u.pm * BM + wr * 64 + fr, col0 = colt + wc * 32 + 8 * fq;
#pragma unroll
        for (int ai = 0; ai < 2; ++ai)
#pragma unroll
            for (int m = 0; m < 4; ++m) { const int row = row0 + ai * HALF + m * 16; const float rs = rstd_of(rowss[row]); bf16_t* rowp = base + (size_t)row * ldc + col0;
#pragma unroll
                for (int bj = 0; bj < 2; ++bj) { f32x4 v0 = acc[ai][bj][m][0] * rs, v1 = acc[ai][bj][m][1] * rs;
                    if (act == 1) {
#pragma unroll
                        for (int j = 0; j < 4; ++j) { v0[j] = gelu_tanh_f(v0[j]); v1[j] = gelu_tanh_f(v1[j]); } }
                    else if (act == 2) {
#pragma unroll
                        for (int j = 0; j < 4; ++j) { v0[j] = sigmoid_f(v0[j]); v1[j] = sigmoid_f(v1[j]); } }
                    u32x4 w; w.x = cvt_pk_bf16(v0[0], v0[1]); w.y = cvt_pk_bf16(v0[2], v0[3]); w.z = cvt_pk_bf16(v1[0], v1[1]); w.w = cvt_pk_bf16(v1[2], v1[3]);
                    *(u32x4*)(rowp + bj * HALF) = w; } }
    }
};
struct EpiResid {
    static constexpr bool PERM = false, AFTER_DRAIN = false;
    const float* base; float* out; bf16_t* outb; float* rowss;
    __device__ __forceinline__ void operator()(f32x4 (&acc)[2][2][4][2], const Unit& u, int wr, int wc, int fr, int fq) const {
        asm volatile("" : "+v"(fr), "+v"(fq));
        const int row0 = u.pm * BM + wr * 64 + fr, col0 = u.pn * BM + wc * 32 + 4 * fq;
#pragma unroll
        for (int ai = 0; ai < 2; ++ai)
#pragma unroll
            for (int m = 0; m < 4; ++m) { const int row = row0 + ai * HALF + m * 16; const size_t off = (size_t)row * 4096 + col0; float s = 0.f;
#pragma unroll
                for (int bj = 0; bj < 2; ++bj)
#pragma unroll
                    for (int n = 0; n < 2; ++n) { const size_t o = off + bj * HALF + n * 16; const f32x4 bs = *(const f32x4*)(base + o); const f32x4 x = bs + acc[ai][bj][m][n];
                        *(f32x4*)(out + o) = x; s += (x[0] * x[0] + x[1] * x[1]) + (x[2] * x[2] + x[3] * x[3]);
                        u32x2 w; w.x = cvt_pk_bf16(x[0], x[1]); w.y = cvt_pk_bf16(x[2], x[3]); *(u32x2*)(outb + o) = w; }
                s += __shfl_xor(s, 16); s += __shfl_xor(s, 32);
                if (fq == 0) __hip_atomic_fetch_add(rowss + row, s, __ATOMIC_RELAXED, __HIP_MEMORY_SCOPE_AGENT); }
    }
};
struct EpiGateT {
    static constexpr bool PERM = false, AFTER_DRAIN = false;
    const bf16_t* G; float* T;
    __device__ __forceinline__ void operator()(f32x4 (&acc)[2][2][4][2], const Unit& u, int wr, int wc, int fr, int fq) const {
        asm volatile("" : "+v"(fr), "+v"(fq));
        const int row0 = u.pm * BM + wr * 64 + fr, col0 = u.pn * BM + wc * 32 + 4 * fq;
#pragma unroll
        for (int ai = 0; ai < 2; ++ai)
#pragma unroll
            for (int m = 0; m < 4; ++m) { const size_t off = (size_t)(row0 + ai * HALF + m * 16) * 4096 + col0;
#pragma unroll
                for (int bj = 0; bj < 2; ++bj)
#pragma unroll
                    for (int n = 0; n < 2; ++n) { const size_t o = off + bj * HALF + n * 16; const u32x2 g = *(const u32x2*)(G + o);
                        const f32x4 gv = {bf_lo(g.x), bf_hi(g.x), bf_lo(g.y), bf_hi(g.y)}; *(f32x4*)(T + o) = gv * acc[ai][bj][m][n]; } }
    }
};
struct EpiMerge {
    static constexpr bool PERM = false, AFTER_DRAIN = false;
    const bf16_t* G; const float* T; bf16_t* O;
    __device__ __forceinline__ void operator()(f32x4 (&acc)[2][2][4][2], const Unit& u, int wr, int wc, int fr, int fq) const {
        asm volatile("" : "+v"(fr), "+v"(fq));
        const int row0 = u.pm * BM + wr * 64 + fr, col0 = u.pn * BM + wc * 32 + 4 * fq;
#pragma unroll
        for (int ai = 0; ai < 2; ++ai)
#pragma unroll
            for (int m = 0; m < 4; ++m) { const size_t off = (size_t)(row0 + ai * HALF + m * 16) * 4096 + col0;
#pragma unroll
                for (int bj = 0; bj < 2; ++bj)
#pragma unroll
                    for (int n = 0; n < 2; ++n) { const size_t o = off + bj * HALF + n * 16; const u32x2 g = *(const u32x2*)(G + o); const f32x4 t = *(const f32x4*)(T + o);
                        const f32x4 gv = {bf_lo(g.x), bf_hi(g.x), bf_lo(g.y), bf_hi(g.y)}; const f32x4 x = t + gv * acc[ai][bj][m][n];
                        u32x2 w; w.x = cvt_pk_bf16(x[0], x[1]); w.y = cvt_pk_bf16(x[2], x[3]); *(u32x2*)(O + o) = w; } }
    }
};
struct EpiBf16Stat {
    static constexpr bool PERM = true, AFTER_DRAIN = false;
    bf16_t* O; float* rowss;
    __device__ __forceinline__ void operator()(f32x4 (&acc)[2][2][4][2], const Unit& u, int wr, int wc, int fr, int fq) const {
        asm volatile("" : "+v"(fr), "+v"(fq));
        const int row0 = u.pm * BM + wr * 64 + fr, col0 = u.pn * BM + wc * 32 + 8 * fq;
#pragma unroll
        for (int ai = 0; ai < 2; ++ai)
#pragma unroll
            for (int m = 0; m < 4; ++m) { const int row = row0 + ai * HALF + m * 16; bf16_t* rowp = O + (size_t)row * 4096 + col0; float s = 0.f;
#pragma unroll
                for (int bj = 0; bj < 2; ++bj) { const f32x4 v0 = acc[ai][bj][m][0], v1 = acc[ai][bj][m][1];
                    s += (v0[0] * v0[0] + v0[1] * v0[1]) + (v0[2] * v0[2] + v0[3] * v0[3]) + (v1[0] * v1[0] + v1[1] * v1[1]) + (v1[2] * v1[2] + v1[3] * v1[3]);
                    u32x4 w; w.x = cvt_pk_bf16(v0[0], v0[1]); w.y = cvt_pk_bf16(v0[2], v0[3]); w.z = cvt_pk_bf16(v1[0], v1[1]); w.w = cvt_pk_bf16(v1[2], v1[3]);
                    *(u32x4*)(rowp + bj * HALF) = w; }
                s += __shfl_xor(s, 16); s += __shfl_xor(s, 32);
                if (fq == 0) __hip_atomic_fetch_add(rowss + row, s, __ATOMIC_RELAXED, __HIP_MEMORY_SCOPE_AGENT); }
    }
};
struct EpiPle {
    static constexpr bool PERM = false, AFTER_DRAIN = false;
    const float* X2; const bf16_t* Eraw; const float* rowss2; const float* rowsse; const float* gple; float* out; float* rowss3;
    __device__ __forceinline__ void operator()(f32x4 (&acc)[2][2][4][2], const Unit& u, int wr, int wc, int fr, int fq) const {
        asm volatile("" : "+v"(fr), "+v"(fq));
        const int row0 = u.pm * BM + wr * 64 + fr, col0 = u.pn * BM + wc * 32 + 4 * fq;
        f32x4 gp[2][2];
#pragma unroll
        for (int bj = 0; bj < 2; ++bj)
#pragma unroll
            for (int n = 0; n < 2; ++n) gp[bj][n] = *(const f32x4*)(gple + col0 + bj * HALF + n * 16);
#pragma unroll
        for (int ai = 0; ai < 2; ++ai)
#pragma unroll
            for (int m = 0; m < 4; ++m) { const int row = row0 + ai * HALF + m * 16; const size_t off = (size_t)row * 4096 + col0; float s = 0.f;
                const float rs2 = rstd_of(rowss2[row]), rse = rstd_of(rowsse[row]);
#pragma unroll
                for (int bj = 0; bj < 2; ++bj)
#pragma unroll
                    for (int n = 0; n < 2; ++n) { const size_t o = off + bj * HALF + n * 16; const u32x2 e = *(const u32x2*)(Eraw + o); const f32x4 xb = *(const f32x4*)(X2 + o);
                        const f32x4 ev = {bf_lo(e.x), bf_hi(e.x), bf_lo(e.y), bf_hi(e.y)}; const f32x4 z = acc[ai][bj][m][n] * rs2; f32x4 x;
#pragma unroll
                        for (int j = 0; j < 4; ++j) x[j] = xb[j] + sigmoid_f(z[j]) * (ev[j] * rse * gp[bj][n][j]);
                        *(f32x4*)(out + o) = x; s += (x[0] * x[0] + x[1] * x[1]) + (x[2] * x[2] + x[3] * x[3]); }
                s += __shfl_xor(s, 16); s += __shfl_xor(s, 32);
                if (fq == 0) __hip_atomic_fetch_add(rowss3 + row, s, __ATOMIC_RELAXED, __HIP_MEMORY_SCOPE_AGENT); }
    }
};
struct EpiUpConv {
    static constexpr bool PERM = true, AFTER_DRAIN = false;
    const float* rowss1; const float* cw; const float* cbias; bf16_t* ACT; float* HALO; float* HEAD; PG8_LAS float* xh;
    __device__ __forceinline__ void operator()(f32x4 (&acc)[2][2][4][2], const Unit& u, int wr, int wc, int fr, int fq) const {
        asm volatile("" : "+v"(fr), "+v"(fq));
        const int row0 = u.pm * BM + wr * 64 + fr, tcol = wc * 32 + 8 * fq;
        const int lane = fq * 16 + fr;
#pragma unroll
        for (int ai = 0; ai < 2; ++ai)
#pragma unroll
            for (int m = 0; m < 4; ++m) { const float rs = rstd_of(rowss1[row0 + ai * HALF + m * 16]);
#pragma unroll
                for (int bj = 0; bj < 2; ++bj)
#pragma unroll
                    for (int n = 0; n < 2; ++n) acc[ai][bj][m][n] = acc[ai][bj][m][n] * rs; }
        if (fr >= 14) {
            PG8_LAS float* xw = xh + (wr * 2 + (fr - 14)) * 256 + tcol;
            float* hw = HALO + ((size_t)u.pm * 2 + (fr - 14)) * 24576 + u.pn * BM + tcol;
#pragma unroll
            for (int bj = 0; bj < 2; ++bj)
#pragma unroll
                for (int n = 0; n < 2; ++n) { *(PG8_LAS f32x4*)(xw + 128 * bj + 4 * n) = acc[0][bj][3][n];
                    if (wr == 0) *(PG8_LAS f32x4*)(xw + 1024 + 128 * bj + 4 * n) = acc[1][bj][3][n]; else *(f32x4*)(hw + 128 * bj + 4 * n) = acc[1][bj][3][n]; }
        }
        if (fr < 2 && wr == 0) {
#pragma unroll
            for (int bj = 0; bj < 2; ++bj)
#pragma unroll
                for (int n = 0; n < 2; ++n) { const int c = 128 * bj + tcol + 4 * n; *(f32x4*)(HEAD + ((size_t)u.pm * 2 + fr) * 24576 + u.pn * BM + c) = acc[0][bj][0][n]; }
        }
        asm volatile("s_waitcnt lgkmcnt(0)" ::: "memory"); __builtin_amdgcn_s_barrier(); asm volatile("" ::: "memory");
        const int s1 = (lane & 48) | ((fr + 15) & 15), s2 = (lane & 48) | ((fr + 14) & 15);
        const int gcol0 = u.pn * 128 + tcol;
#pragma unroll
        for (int n = 0; n < 2; ++n) {
            f32x4 wg[3], wv[3], bg, bv;
#pragma unroll
            for (int k = 0; k < 3; ++k) { wg[k] = *(const f32x4*)(cw + (size_t)k * 24576 + gcol0 + 4 * n); wv[k] = *(const f32x4*)(cw + (size_t)k * 24576 + 12288 + gcol0 + 4 * n); }
            bg = *(const f32x4*)(cbias + gcol0 + 4 * n); bv = *(const f32x4*)(cbias + 12288 + gcol0 + 4 * n);
#pragma unroll
            for (int ai = 0; ai < 2; ++ai) { const int k = 2 * ai + wr;
                f32x4 pg = {0.f, 0.f, 0.f, 0.f}, pv = {0.f, 0.f, 0.f, 0.f};
                if (k >= 1 && fr >= 14) { pg = *(const PG8_LAS f32x4*)(xh + ((k - 1) * 2 + (fr - 14)) * 256 + tcol + 4 * n); pv = *(const PG8_LAS f32x4*)(xh + ((k - 1) * 2 + (fr - 14)) * 256 + 128 + tcol + 4 * n); }
                f32x4 r1pg, r2pg, r1pv, r2pv;
#pragma unroll
                for (int j = 0; j < 4; ++j) { r1pg[j] = __shfl(pg[j], s1); r2pg[j] = __shfl(pg[j], s2); r1pv[j] = __shfl(pv[j], s1); r2pv[j] = __shfl(pv[j], s2); }
#pragma unroll
                for (int m = 0; m < 4; ++m) { const f32x4 cg = acc[ai][0][m][n], cv = acc[ai][1][m][n]; f32x4 r1g, r2g, r1v, r2v, o;
#pragma unroll
                    for (int j = 0; j < 4; ++j) { r1g[j] = __shfl(cg[j], s1); r2g[j] = __shfl(cg[j], s2); r1v[j] = __shfl(cv[j], s1); r2v[j] = __shfl(cv[j], s2); }
#pragma unroll
                    for (int j = 0; j < 4; ++j) { const float p1g = fr >= 1 ? r1g[j] : r1pg[j], p2g = fr >= 2 ? r2g[j] : r2pg[j], p1v = fr >= 1 ? r1v[j] : r1pv[j], p2v = fr >= 2 ? r2v[j] : r2pv[j];
                        const float yg = wg[0][j] * p2g + wg[1][j] * p1g + wg[2][j] * cg[j] + bg[j], yv = wv[0][j] * p2v + wv[1][j] * p1v + wv[2][j] * cv[j] + bv[j];
                        o[j] = gelu_tanh_f(yg) * yv; }
                    u32x2 w; w.x = cvt_pk_bf16(o[0], o[1]); w.y = cvt_pk_bf16(o[2], o[3]);
                    *(u32x2*)(ACT + (size_t)(row0 + ai * HALF + m * 16) * 12288 + gcol0 + 4 * n) = w;
                    r1pg = r1g; r2pg = r2g; r1pv = r1v; r2pv = r2v; }
            }
        }
    }
};

template <class Epi, class Sched, bool ALIGN_EPI = false, bool SP2 = false>
__device__ __forceinline__ void gemm_phase(PG8_LAS unsigned char* lds, const Gemm g, const Sched& S, const Epi& E, const int wid  ) {
    int lane = (int)__builtin_amdgcn_mbcnt_hi(~0u, __builtin_amdgcn_mbcnt_lo(~0u, 0u)); asm volatile("" : "+v"(lane));
    const int tid = wid * 64 + lane, wr = wid >> 2, wc = wid & 3, fr = lane & 15, fq = lane >> 4;
    const int K = g.K, nt = K / BK;
    unsigned voffA[2], voffB[2];
#pragma unroll
    for (int i = 0; i < 2; ++i) { int R, C; stage_rc(tid * 16 + i * 8192, R, C); const int Rb = Epi::PERM ? ((R & ~31) + perm32(R & 31)) : R;
        voffA[i] = (unsigned)(R * K + C) * 2u; voffB[i] = (unsigned)(Rb * K + C) * 2u; }
    const size_t kstep = (size_t)(BK * 2);
    const size_t hstep = (size_t)HALF * K * 2;
    const size_t tstep = 2 * hstep;
    const unsigned ldsw = (unsigned)wid * 1024u;
    const int aoff = lds_byte(wr * 64 + fr, fq * 8), boff = lds_byte(wc * 32 + fr, fq * 8);
#define PG8_SA(b, h) (((b) * 2 + (h)) * HTB)
#define PG8_SB(b, h) ((4 + (b) * 2 + (h)) * HTB)
#define PG8_STAGE(bufoff, gbase, voff) do { _Pragma("unroll") for (int _i = 0; _i < 2; ++_i) \
        __builtin_amdgcn_global_load_lds((const unsigned*)((const char*)(gbase) + (voff)[_i]), (PG8_LAS unsigned*)(lds + (bufoff) + ldsw + _i * 8192), 16, 0, 0); } while (0)
#define PG8_LDA(dst, b, h) do { _Pragma("unroll") for (int m = 0; m < 4; ++m) _Pragma("unroll") for (int k = 0; k < 2; ++k) dst[m][k] = *(const PG8_LAS bf16x8*)(lds + PG8_SA(b, h) + aoff + m * 2048 + k * 1024); } while (0)
#define PG8_LDB(dst, b, h) do { _Pragma("unroll") for (int n = 0; n < 2; ++n) _Pragma("unroll") for (int k = 0; k < 2; ++k) dst[n][k] = *(const PG8_LAS bf16x8*)(lds + PG8_SB(b, h) + boff + n * 2048 + k * 1024); } while (0)
#define PG8_MMA(ai, bj, At, Bt) do { __builtin_amdgcn_s_setprio(1); _Pragma("unroll") for (int m = 0; m < 4; ++m) _Pragma("unroll") for (int n = 0; n < 2; ++n) _Pragma("unroll") for (int k = 0; k < 2; ++k) \
        acc[ai][bj][m][n] = __builtin_amdgcn_mfma_f32_16x16x32_bf16(Bt[n][k], At[m][k], acc[ai][bj][m][n], 0, 0, 0); __builtin_amdgcn_s_setprio(0); } while (0)
#define PG8_WAIT_V(n) asm volatile("s_waitcnt vmcnt(" #n ")" ::: "memory")
#define PG8_WAIT_L(n) asm volatile("s_waitcnt lgkmcnt(" #n ")" ::: "memory")
#define PG8_BAR __builtin_amdgcn_s_barrier()
#define PG8_SCHED __builtin_amdgcn_sched_barrier(0)
    Unit cur, nxt; int ui = 0;
    if (!S.next(0, cur)) return;
    f32x4 acc[2][2][4][2];
#pragma unroll
    for (int a = 0; a < 2; ++a)
#pragma unroll
        for (int b = 0; b < 2; ++b)
#pragma unroll
            for (int m = 0; m < 4; ++m)
#pragma unroll
                for (int n = 0; n < 2; ++n) acc[a][b][m][n] = (f32x4){0.f, 0.f, 0.f, 0.f};
    bf16x8 At[4][2], B0[2][2], B1[2][2];
    const char* cA = (const char*)g.A + (size_t)cur.pm * tstep; const char* cB = (const char*)g.Bt + (size_t)cur.pn * tstep;
    S.a_ready(cur);
    if constexpr (SP2) {
        PG8_STAGE(PG8_SB(0, 0), cB, voffB); PG8_STAGE(PG8_SB(0, 1), cB + hstep, voffB); PG8_STAGE(PG8_SA(0, 0), cA, voffA); PG8_STAGE(PG8_SA(0, 1), cA + hstep, voffA);
        if (wr == 1) PG8_BAR;
        PG8_WAIT_V(2); PG8_BAR;
        PG8_STAGE(PG8_SB(1, 0), cB + kstep, voffB); PG8_STAGE(PG8_SA(1, 0), cA + kstep, voffA); PG8_STAGE(PG8_SB(1, 1), cB + hstep + kstep, voffB);
        PG8_WAIT_V(6); PG8_BAR;
    } else {
        PG8_STAGE(PG8_SB(0, 0), cB, voffB); PG8_STAGE(PG8_SA(0, 0), cA, voffA); PG8_STAGE(PG8_SB(0, 1), cB + hstep, voffB); PG8_STAGE(PG8_SA(0, 1), cA + hstep, voffA);
        if (wr == 1) PG8_BAR;
        PG8_WAIT_V(4); PG8_BAR;
        PG8_STAGE(PG8_SB(1, 0), cB + kstep, voffB); PG8_STAGE(PG8_SA(1, 0), cA + kstep, voffA); PG8_STAGE(PG8_SB(1, 1), cB + hstep + kstep, voffB);
        PG8_WAIT_V(6); PG8_BAR;
    }
    for (;;) {
        const bool has_next = S.next(ui + 1, nxt);
        const char* nA = has_next ? (const char*)g.A + (size_t)nxt.pm * tstep : cA; const char* nB = has_next ? (const char*)g.Bt + (size_t)nxt.pn * tstep : cB;
        for (int t = 0; t < nt; t += 2) {
            const bool last = (t == nt - 2);
            const char* a1 = cA + (size_t)(t + 1) * kstep;
            const char* a2 = last ? nA : cA + (size_t)(t + 2) * kstep; const char* b2 = last ? nB : cB + (size_t)(t + 2) * kstep;
            const char* a3 = a2 + kstep; const char* b3 = b2 + kstep;
            if (last && has_next) S.a_ready(nxt);
            if constexpr (SP2) {
            PG8_LDB(B0, 0, 0); PG8_LDB(B1, 0, 1); PG8_SCHED; PG8_LDA(At, 0, 0); PG8_STAGE(PG8_SA(1, 1), a1 + hstep, voffA);
            PG8_WAIT_V(8); PG8_WAIT_L(0); PG8_BAR; PG8_MMA(0, 0, At, B0); PG8_MMA(0, 1, At, B1); PG8_BAR; PG8_SCHED;
            PG8_LDA(At, 0, 1); PG8_STAGE(PG8_SB(0, 0), b2, voffB); PG8_STAGE(PG8_SB(0, 1), b2 + hstep, voffB); PG8_STAGE(PG8_SA(0, 0), a2, voffA);
            PG8_WAIT_V(8); PG8_WAIT_L(0); PG8_BAR; PG8_MMA(1, 0, At, B0); PG8_MMA(1, 1, At, B1); PG8_BAR; PG8_SCHED;
            PG8_LDB(B0, 1, 0); PG8_LDB(B1, 1, 1); PG8_SCHED; PG8_LDA(At, 1, 0); PG8_STAGE(PG8_SA(0, 1), a2 + hstep, voffA);
            PG8_WAIT_V(8); PG8_WAIT_L(0); PG8_BAR; PG8_MMA(0, 0, At, B0); PG8_MMA(0, 1, At, B1); PG8_BAR; PG8_SCHED;
            PG8_LDA(At, 1, 1); PG8_STAGE(PG8_SB(1, 0), b3, voffB); PG8_STAGE(PG8_SB(1, 1), b3 + hstep, voffB); PG8_STAGE(PG8_SA(1, 0), a3, voffA);
            PG8_WAIT_V(8); PG8_WAIT_L(0); PG8_BAR; PG8_MMA(1, 0, At, B0); PG8_MMA(1, 1, At, B1); PG8_BAR; PG8_SCHED;
            } else {
            PG8_LDB(B0, 0, 0); PG8_SCHED; PG8_LDA(At, 0, 0); PG8_STAGE(PG8_SA(1, 1), a1 + hstep, voffA);
            PG8_WAIT_L(8); PG8_BAR; PG8_WAIT_L(0); PG8_MMA(0, 0, At, B0); PG8_BAR; PG8_SCHED;
            PG8_LDB(B1, 0, 1); PG8_STAGE(PG8_SB(0, 0), b2, voffB);
            PG8_BAR; PG8_WAIT_L(0); PG8_MMA(0, 1, At, B1); PG8_BAR;
            PG8_LDA(At, 0, 1); PG8_STAGE(PG8_SA(0, 0), a2, voffA);
            PG8_BAR; PG8_WAIT_L(0); PG8_MMA(1, 0, At, B0); PG8_BAR; PG8_SCHED;
            PG8_STAGE(PG8_SB(0, 1), b2 + hstep, voffB);
            PG8_WAIT_V(6); PG8_BAR; PG8_MMA(1, 1, At, B1); PG8_BAR;
            PG8_LDB(B0, 1, 0); PG8_SCHED; PG8_LDA(At, 1, 0); PG8_STAGE(PG8_SA(0, 1), a2 + hstep, voffA);
            PG8_WAIT_L(8); PG8_BAR; PG8_WAIT_L(0); PG8_MMA(0, 0, At, B0); PG8_BAR; PG8_SCHED;
            PG8_LDB(B1, 1, 1); PG8_STAGE(PG8_SB(1, 0), b3, voffB);
            PG8_BAR; PG8_WAIT_L(0); PG8_MMA(0, 1, At, B1); PG8_BAR;
            PG8_LDA(At, 1, 1); PG8_STAGE(PG8_SA(1, 0), a3, voffA);
            PG8_BAR; PG8_WAIT_L(0); PG8_MMA(1, 0, At, B0); PG8_BAR; PG8_SCHED;
            PG8_STAGE(PG8_SB(1, 1), b3 + hstep, voffB);
            PG8_WAIT_V(6); PG8_BAR; PG8_MMA(1, 1, At, B1); PG8_BAR;
            }
        }
        if constexpr (ALIGN_EPI) { if (wr == 0) PG8_BAR; }
        if constexpr (!Epi::AFTER_DRAIN) { E(acc, cur, wr, wc, fr, fq); S.done(cur); }
        if (!has_next) break;
#pragma unroll
        for (int a = 0; a < 2; ++a)
#pragma unroll
            for (int b = 0; b < 2; ++b)
#pragma unroll
                for (int m = 0; m < 4; ++m)
#pragma unroll
                    for (int n = 0; n < 2; ++n) acc[a][b][m][n] = (f32x4){0.f, 0.f, 0.f, 0.f};
        cur = nxt; cA = nA; cB = nB; ++ui;
        if constexpr (ALIGN_EPI) { if (wr == 1) PG8_BAR; }
    }
    PG8_WAIT_V(0);
    if constexpr (!ALIGN_EPI) { if (wr == 0) PG8_BAR; }
    PG8_BAR;
    if constexpr (Epi::AFTER_DRAIN) { E.fused(acc, cur, wr, wc, fr, fq, lds, wid, lane); S.done(cur); }
#undef PG8_SA
#undef PG8_SB
#undef PG8_STAGE
#undef PG8_LDA
#undef PG8_LDB
#undef PG8_MMA
#undef PG8_WAIT_V
#undef PG8_WAIT_L
#undef PG8_BAR
#undef PG8_SCHED
}
}
constexpr int NWAVES = 8;
#ifndef MK_N_LAUNCHES
#define MK_N_LAUNCHES 1
#endif
constexpr int NPH = 11;
constexpr int N_LAUNCHES = MK_N_LAUNCHES;
static_assert(N_LAUNCHES == 1 || N_LAUNCHES == NPH, "MK_N_LAUNCHES is 1 or 11");

constexpr int BATCH = 4, SEQ = 4096, D = 4096, M = BATCH * SEQ;
constexpr int ATT_W = 3072, IN_COLS = 25600, FFN = 12288, PLE = 256;
constexpr size_t MiB = 1u << 20;
constexpr size_t WS_CTL = 0, CTL_ZERO_BYTES = 1 * MiB;
constexpr size_t WS_LSE = 2 * MiB;
constexpr size_t WS_PB = 4 * MiB;
constexpr size_t WS_WUP = 16 * MiB, WS_WDOWN = 208 * MiB, WS_WPG = 304 * MiB, WS_WATT = 336 * MiB, WS_WLRU = 360 * MiB, WS_WOUT = 392 * MiB;
constexpr size_t WS_WPP = 424 * MiB, WS_WRG = 426 * MiB, WS_WIG = 428 * MiB;
constexpr size_t WS_WIN = 432 * MiB, WS_XB = 632 * MiB;
constexpr size_t WS_Q = 760 * MiB, WS_K = 856 * MiB, WS_V = 952 * MiB, WS_XR = 1048 * MiB, WS_YG = 1176 * MiB, WS_GA = 1304 * MiB, WS_GR = 1432 * MiB;
constexpr size_t WS_O = 432 * MiB, WS_XC = 528 * MiB;
constexpr size_t WS_LRU = WS_YG;
constexpr size_t WS_T = 760 * MiB, WS_MRG = 1048 * MiB;
constexpr size_t WS_X1 = 432 * MiB, WS_X1B = 1176 * MiB;
constexpr size_t WS_ACT = 688 * MiB;
constexpr size_t WS_X2B = 1304 * MiB, WS_ERAW = 1432 * MiB;
constexpr size_t WS_HALO = 1560 * MiB, WS_HEAD = 1572 * MiB, WS_END = 1584 * MiB;
constexpr int CW_BAR = 4096;
constexpr size_t CTL_RSS1 = 256 * 1024, CTL_RSS2 = 320 * 1024, CTL_RSS3 = 384 * 1024, CTL_RSSE = 448 * 1024, CTL_RSS0 = 512 * 1024;
constexpr int RING_OFF = 0, MISC_OFF = 135168, XH_OFF = 139264, LDS_BYTES = 147456;

#define GAS __attribute__((address_space(1)))
#define LAS __attribute__((address_space(3)))
typedef unsigned short bf16;
typedef unsigned v4u __attribute__((ext_vector_type(4)));
typedef float f32x4 __attribute__((ext_vector_type(4)));
typedef short bf16x8 __attribute__((ext_vector_type(8)));
typedef GAS unsigned gu32;
typedef GAS unsigned long long gu64;
#define RLX_AGENT __ATOMIC_RELAXED, __HIP_MEMORY_SCOPE_AGENT
#define LDS_WAIT() asm volatile("s_waitcnt lgkmcnt(0)" ::: "memory")
#define VM_WAIT() asm volatile("s_waitcnt vmcnt(0)" ::: "memory")
__device__ __forceinline__ unsigned long long rt() { return __builtin_amdgcn_s_memrealtime(); }
__device__ __forceinline__ unsigned f2bf(float f) { unsigned u = __builtin_bit_cast(unsigned, f); return (u + 0x7fffu + ((u >> 16) & 1u)) >> 16; }
__device__ __forceinline__ unsigned pk2(float lo, float hi) { return f2bf(lo) | (f2bf(hi) << 16); }

#define XB_TMO      128
#define XB_XCNT(j)  (256  + 64 * (j))
#define XB_XSUB(j)  (1280 + 64 * (j))
#define XB_XGEN(j)  (2304 + 64 * (j))
#define XB_TOP      3328
#define XB_TOPGEN   3392
#define XCD_BAR_WORDS 3456
#define XB_SPIN_CAP (1u << 18)

__device__ __forceinline__ unsigned xb_ld(unsigned* p)              { return __hip_atomic_load(p, __ATOMIC_RELAXED, __HIP_MEMORY_SCOPE_AGENT); }
__device__ __forceinline__ unsigned xb_add(unsigned* p, unsigned v) { return __hip_atomic_fetch_add(p, v, __ATOMIC_RELAXED, __HIP_MEMORY_SCOPE_AGENT); }
__device__ __forceinline__ unsigned xb_xcc_id() { return (unsigned)__builtin_amdgcn_s_getreg((3 << 11) | 20) & 0xFu; }
#define XB_SPIN(cond, bar) do { unsigned _sp = 0; while (cond) { __builtin_amdgcn_s_sleep(1); \
    if ((++_sp & 255u) == 0u) { if (xb_ld(&(bar)[XB_TMO])) break; if (_sp > XB_SPIN_CAP) { atomicAdd(&(bar)[XB_TMO], 1u); break; } } } } while (0)

struct XcdBarrier {
    unsigned* bar; unsigned x;
    volatile LAS unsigned* st;
};

__device__ __forceinline__ XcdBarrier xcd_barrier_post(unsigned* bar, volatile LAS unsigned* st, const bool t0  ) {
    XcdBarrier b; b.bar = bar; b.x = xb_xcc_id(); b.st = st;
    if (t0) (void)xb_add(&bar[XB_XCNT(b.x)], 1u);
    return b;
}
__device__ __forceinline__ void xcd_barrier_complete(unsigned* bar, unsigned x, unsigned& nloc, unsigned& nx) {
    const unsigned G = gridDim.x * gridDim.y * gridDim.z;
    unsigned sum, cnt, mine, sp = 0u;
    for (;;) {
        sum = 0u; cnt = 0u; mine = 0u;
#pragma unroll
        for (unsigned j = 0; j < 16; ++j) { const unsigned c = xb_ld(&bar[XB_XCNT(j)]); sum += c; cnt += (c > 0u) ? 1u : 0u; mine = (j == x) ? c : mine; }
        if (sum == G) break;
        __builtin_amdgcn_s_sleep(1);
        if ((++sp & 255u) == 0u) { if (xb_ld(&bar[XB_TMO])) break; if (sp > XB_SPIN_CAP) { atomicAdd(&bar[XB_TMO], 1u); break; } }
    }
    nloc = mine > 0u ? mine : 1u; nx = cnt > 0u ? cnt : 1u;
}

__device__ __forceinline__ void xcd_barrier(const XcdBarrier& b, const bool t0) {
    asm volatile("s_waitcnt vmcnt(0)" ::: "memory");
    __syncthreads();
    if (t0) {
        unsigned* bar = b.bar;
        __builtin_amdgcn_s_waitcnt(0);
        unsigned nloc = b.st[0], nx = b.st[1];
        if (nloc == 0u) { xcd_barrier_complete(bar, b.x, nloc, nx); b.st[0] = nloc; b.st[1] = nx; }
        const unsigned old = xb_add(&bar[XB_XSUB(b.x)], 1u);
        const unsigned gen = old / nloc;
        if (old + 1u == (gen + 1u) * nloc) {
            __builtin_amdgcn_fence(__ATOMIC_RELEASE, "agent");
            asm volatile("s_waitcnt vmcnt(0)" ::: "memory");
            const unsigned og = xb_add(&bar[XB_TOP], 1u);
            const unsigned tg = og / nx;
            if (og + 1u == (tg + 1u) * nx) xb_add(&bar[XB_TOPGEN], 1u);
            else XB_SPIN(xb_ld(&bar[XB_TOPGEN]) == tg, bar);
            __builtin_amdgcn_fence(__ATOMIC_ACQUIRE, "agent");
            xb_add(&bar[XB_XGEN(b.x)], 1u);
            asm volatile("s_waitcnt vmcnt(0)" ::: "memory");
        } else {
            XB_SPIN(xb_ld(&bar[XB_XGEN(b.x)]) == gen, bar);
            __builtin_amdgcn_fence(__ATOMIC_ACQUIRE, "agent");
            asm volatile("s_waitcnt vmcnt(0)" ::: "memory");
        }
    }
    __syncthreads();
}

struct Frame {
    LAS unsigned char* lds; volatile LAS unsigned* MISC; gu32* ctl;
    int vcu, G, wave;
    const float* const* in; float* out; unsigned char* ws;
};
__device__ __forceinline__ int opaque_lane() { int l = (int)__builtin_amdgcn_mbcnt_hi(~0u, __builtin_amdgcn_mbcnt_lo(~0u, 0u)); asm volatile("" : "+v"(l)); return l; }
#define THREAD_COORDS() const int lane = opaque_lane(), wave = F.wave, tid = wave * 64 + lane; (void)tid
__device__ __forceinline__ float wave_sum(float v) {
#pragma unroll
    for (int o = 1; o < 64; o <<= 1) v += __shfl_xor(v, o);
    return v;
}
__device__ __forceinline__ unsigned pkbf(float lo, float hi) { return pg8::cvt_pk_bf16(lo, hi); }
using pg8::bf_lo; using pg8::bf_hi; using pg8::sigmoid_f; using pg8::gelu_tanh_f; using pg8::rstd_of;
typedef unsigned u32x2 __attribute__((ext_vector_type(2)));

__device__ __forceinline__ void p0_item_load(f32x4 (&v)[8], const float* W, int N, int scol0, int k0, int lane) {
#pragma unroll
    for (int i = 0; i < 8; ++i) v[i] = *(const GAS f32x4*)(W + (size_t)(k0 + 8 * i + (lane >> 3)) * N + scol0 + 4 * (lane & 7));
}
__device__ __forceinline__ void p0_item_store(const f32x4 (&v)[8], int K, bf16* WT, int nrow0, int k0, const float* g, LAS float* scr, int lane) {
#pragma unroll
    for (int i = 0; i < 8; ++i) { LAS float* d = scr + (8 * i + (lane >> 3)) * 33 + 4 * (lane & 7); d[0] = v[i][0]; d[1] = v[i][1]; d[2] = v[i][2]; d[3] = v[i][3]; }
    const int c = lane & 7; f32x4 g0 = {1.f, 1.f, 1.f, 1.f}, g1 = g0; if (g) { g0 = *(const GAS f32x4*)(g + k0 + 8 * c); g1 = *(const GAS f32x4*)(g + k0 + 8 * c + 4); }
    LDS_WAIT(); asm volatile("" ::: "memory");
#pragma unroll
    for (int j = 0; j < 4; ++j) { const int n = (lane >> 3) + 8 * j; const LAS float* s = scr + (8 * c) * 33 + n;
        v4u o; o.x = pkbf(s[0 * 33] * g0[0], s[1 * 33] * g0[1]); o.y = pkbf(s[2 * 33] * g0[2], s[3 * 33] * g0[3]); o.z = pkbf(s[4 * 33] * g1[0], s[5 * 33] * g1[1]); o.w = pkbf(s[6 * 33] * g1[2], s[7 * 33] * g1[3]);
        *(GAS v4u*)(WT + (size_t)(nrow0 + n) * K + k0 + 8 * c) = o; }
    LDS_WAIT(); asm volatile("" ::: "memory");
}
struct WSpec { const float* W; bf16* WT; const float* g; int K, N, Nd, mode, nmat; };
__device__ __forceinline__ void p0_prologue(Frame& F) {
    THREAD_COORDS();
    LAS float* scr = (LAS float*)(F.lds + RING_OFF + wave * 16384);
    const int gw = F.vcu * NWAVES + wave, NGW = F.G * NWAVES;
    unsigned char* ws = F.ws;
    const WSpec specs[10] = {
        {F.in[3],  (bf16*)(ws + WS_WIN),   F.in[2],  4096, IN_COLS, IN_COLS, 0, 1},
        {F.in[15], (bf16*)(ws + WS_WUP),   F.in[14], 4096, 2 * FFN, 2 * FFN, 1, 1},
        {F.in[18], (bf16*)(ws + WS_WDOWN), nullptr,  FFN,  4096, 4096, 0, 1},
        {F.in[11], (bf16*)(ws + WS_WATT),  nullptr,  ATT_W, 4096, 4096, 0, 1},
        {F.in[12], (bf16*)(ws + WS_WLRU),  nullptr,  4096, 4096, 4096, 0, 1},
        {F.in[13], (bf16*)(ws + WS_WOUT),  nullptr,  4096, 4096, 4096, 0, 1},
        {F.in[22], (bf16*)(ws + WS_WPG),   F.in[21], 4096, 4096, 4096, 0, 1},
        {F.in[19], (bf16*)(ws + WS_WPP),   nullptr,  PLE,  4096, 4096, 0, 1},
        {F.in[6],  (bf16*)(ws + WS_WRG),   nullptr,  256,  256, 256, 0, 16},
        {F.in[8],  (bf16*)(ws + WS_WIG),   nullptr,  256,  256, 256, 0, 16}};
    int base = 0;
#pragma unroll
    for (int s = 0; s < 10; ++s) {
        const WSpec sp = specs[s]; const int nblk = sp.Nd / 32, kblk = sp.K / 64, per = nblk * kblk, total = per * sp.nmat;
        int it = gw - (base % NGW); if (it < 0) it += NGW;
#define P0_DECODE(IT, WP, SC, NR, K0, TP) const int mt_ = (IT) / per, r_ = (IT) % per, kb_ = r_ / nblk, nb_ = r_ % nblk; int SC = 32 * nb_; \
            if (sp.mode == 1) { const int pn_ = nb_ >> 3, c0_ = (nb_ & 7) * 32; SC = c0_ < 128 ? pn_ * 128 + c0_ : FFN + pn_ * 128 + (c0_ - 128); } \
            const float* WP = sp.W + (size_t)mt_ * sp.K * sp.N; bf16* TP = sp.WT + (size_t)mt_ * sp.K * sp.Nd; const int NR = 32 * nb_, K0 = 64 * kb_;
        f32x4 cur[8];
        if (it < total) { P0_DECODE(it, wp, sc, nr, k0, tp) (void)nr; (void)tp; p0_item_load(cur, wp, sp.N, sc, k0, lane); }
        for (; it < total; it += NGW) {
            f32x4 nxt[8]; const int itn = it + NGW;
            if (itn < total) { P0_DECODE(itn, wp, sc, nr, k0, tp) (void)nr; (void)tp; p0_item_load(nxt, wp, sp.N, sc, k0, lane); }
            { P0_DECODE(it, wp, sc, nr, k0, tp) (void)wp; (void)sc; p0_item_store(cur, sp.K, tp, nr, k0, sp.g, scr, lane); }
#pragma unroll
            for (int i = 0; i < 8; ++i) cur[i] = nxt[i];
        }
#undef P0_DECODE
        base += total;
    }
    const float* x = F.in[0]; bf16* xb = (bf16*)(ws + WS_XB); float* rss0 = (float*)(ws + WS_CTL + CTL_RSS0);
    for (int m = gw; m < M; m += NGW) {
        const GAS f32x4* xr = (const GAS f32x4*)(x + (size_t)m * D) + lane; GAS u32x2* o8 = (GAS u32x2*)(xb + (size_t)m * D) + lane; float s = 0.f;
#pragma unroll
        for (int j = 0; j < 16; ++j) { const f32x4 v = xr[64 * j]; s += (v.x * v.x + v.y * v.y) + (v.z * v.z + v.w * v.w); u32x2 w; w.x = pkbf(v.x, v.y); w.y = pkbf(v.z, v.w); o8[64 * j] = w; }
        s = wave_sum(s); if (lane == 0) rss0[m] = s;
    }
    const float* p = F.in[1]; bf16* pb = (bf16*)(ws + WS_PB);
    { const size_t st = (size_t)F.G * 512, tot = (size_t)M * PLE / 4;
      for (size_t i0 = (size_t)(F.vcu * 512 + tid); i0 < tot; i0 += 4 * st) { f32x4 v[4];
#pragma unroll
        for (int k = 0; k < 4; ++k) if (i0 + k * st < tot) v[k] = ((const GAS f32x4*)p)[i0 + k * st];
#pragma unroll
        for (int k = 0; k < 4; ++k) if (i0 + k * st < tot) { u32x2 w; w.x = pkbf(v[k].x, v[k].y); w.y = pkbf(v[k].z, v[k].w); ((GAS u32x2*)pb)[i0 + k * st] = w; } } }
}

typedef short v4i16_t __attribute__((ext_vector_type(4)));
constexpr int AT_V_OFF = 65536;
static_assert(AT_V_OFF + 272 * 256 <= MISC_OFF, "attention LDS");
__device__ __forceinline__ int img_off(int row, int ch) { return 256 * row + 16 * (ch ^ (((row & 3) << 2) | ((row >> 2) & 3))); }
struct AttnCoord { int g, dil, b, h, r, c, cb; };
__device__ __forceinline__ AttnCoord attn_coord(int au) { AttnCoord a; a.g = au >> 10; const int rem = au & 1023; a.dil = a.g == 0 ? 1 : (a.g == 1 ? 4 : 16); const int nb = 32 / a.dil;
    a.b = rem >> 8; a.h = (rem >> 5) & 7; a.r = (rem & 31) / nb; a.c = (rem & 31) % nb; a.cb = a.g * 1024 + a.h * 128; return a; }
__device__ __forceinline__ void attn_units(Frame& F, int first, int count) {
    THREAD_COORDS();
    const bf16* Qb = (const bf16*)(F.ws + WS_Q); const bf16* Kb = (const bf16*)(F.ws + WS_K); const bf16* Vb = (const bf16*)(F.ws + WS_V);
    bf16* Ob = (bf16*)(F.ws + WS_O); float* LSE = (float*)(F.ws + WS_LSE);
    LAS unsigned char* L = F.lds;
    const int w = wave, q = lane & 15, kg = lane >> 4;
    if (tid < 256) { const v4u z = {0u, 0u, 0u, 0u}; *(LAS v4u*)(L + AT_V_OFF + img_off(256 + (tid >> 4), tid & 15)) = z; }
    v4u pk[8], pv[8];
#define AT_LOAD(AU) do { const AttnCoord a_ = attn_coord(AU); const size_t mb_ = (size_t)a_.b * SEQ; \
        _Pragma("unroll") for (int it = 0; it < 8; ++it) { const int x = tid + 512 * it, j = x >> 4, ch = x & 15; const int lk = (a_.c - 1) * 128 + j; const size_t go = (mb_ + (size_t)(lk < 0 ? 0 : lk) * a_.dil + a_.r) * ATT_W + a_.cb + 8 * ch; \
            pk[it] = *(const GAS v4u*)(Kb + go); const v4u vv = *(const GAS v4u*)(Vb + go); const v4u z_ = {0u, 0u, 0u, 0u}; pv[it] = lk < 0 ? z_ : vv; } } while (0)
    AT_LOAD(first);
    for (int ui = 0; ui < count; ++ui) {
        const int au = first + ui; const AttnCoord a = attn_coord(au); const size_t mb = (size_t)a.b * SEQ;
        __syncthreads();
#pragma unroll
        for (int it = 0; it < 8; ++it) { const int x = tid + 512 * it, j = x >> 4, ch = x & 15; const int o = img_off(j, ch); *(LAS v4u*)(L + o) = pk[it]; *(LAS v4u*)(L + AT_V_OFF + o) = pv[it]; }
        const int lq = a.c * 128 + 16 * w + q; const size_t mq = mb + (size_t)lq * a.dil + a.r;
        bf16x8 qf[4];
#pragma unroll
        for (int ks = 0; ks < 4; ++ks) qf[ks] = *(const GAS bf16x8*)(Qb + mq * ATT_W + a.cb + 32 * ks + 8 * kg);
        LDS_WAIT(); __syncthreads();
        if (ui + 1 < count) AT_LOAD(au + 1);
        const int swk = ((q & 3) << 2) | ((q >> 2) & 3); const int kbase = 256 * (16 * w + q);
        f32x4 s[9];
#pragma unroll
        for (int kt = 0; kt < 9; ++kt) { f32x4 acc = {0.f, 0.f, 0.f, 0.f};
#pragma unroll
            for (int ks = 0; ks < 4; ++ks) { const bf16x8 kf = *(const LAS bf16x8*)(L + kbase + kt * 4096 + 16 * ((4 * ks + kg) ^ swk)); acc = __builtin_amdgcn_mfma_f32_16x16x32_bf16(kf, qf[ks], acc, 0, 0, 0); }
            s[kt] = acc; }
        float mx = -1e30f;
#pragma unroll
        for (int kt = 0; kt < 9; ++kt)
#pragma unroll
            for (int e = 0; e < 4; ++e) { const int jmi = 16 * kt + 4 * kg + e - q; const int lk = (a.c - 1) * 128 + 16 * w + 16 * kt + 4 * kg + e;
                const bool ok = (jmi >= 0) && (jmi <= 128) && (lk >= 0); const float v = ok ? s[kt][e] * 0.08838834764831845f : -1e30f; s[kt][e] = v; mx = fmaxf(mx, v); }
        mx = fmaxf(mx, __shfl_xor(mx, 16)); mx = fmaxf(mx, __shfl_xor(mx, 32));
        float den = 0.f; unsigned pp[10][2];
#pragma unroll
        for (int kt = 0; kt < 9; ++kt) {
#pragma unroll
            for (int e = 0; e < 4; ++e) { const float p = __builtin_amdgcn_exp2f((s[kt][e] - mx) * 1.4426950408889634f); s[kt][e] = p; den += p; }
            pp[kt][0] = pkbf(s[kt][0], s[kt][1]); pp[kt][1] = pkbf(s[kt][2], s[kt][3]); }
        pp[9][0] = 0u; pp[9][1] = 0u;
        den += __shfl_xor(den, 16); den += __shfl_xor(den, 32);
        if (kg == 0) LSE[mq * 24 + a.g * 8 + a.h] = mx + __logf(den);
        const float inv = 1.0f / den;
        const int qq = q >> 2, pq = q & 3, swv = (qq << 2) | kg; const int vbase = AT_V_OFF + 256 * (16 * w + 4 * kg + qq) + 8 * (pq & 1);
#pragma unroll
        for (int dt = 0; dt < 8; ++dt) { f32x4 acc = {0.f, 0.f, 0.f, 0.f}; const int vb_ = vbase + 16 * ((2 * dt + (pq >> 1)) ^ swv);
#pragma unroll
            for (int ks = 0; ks < 5; ++ks) {
                const v4i16_t lo = __builtin_amdgcn_ds_read_tr16_b64_v4i16((LAS v4i16_t*)(L + vb_ + ks * 8192)), hi = __builtin_amdgcn_ds_read_tr16_b64_v4i16((LAS v4i16_t*)(L + vb_ + ks * 8192 + 4096));
                const bf16x8 vf = {lo[0], lo[1], lo[2], lo[3], hi[0], hi[1], hi[2], hi[3]};
                const v4u pw = {pp[2 * ks][0], pp[2 * ks][1], pp[2 * ks + 1][0], pp[2 * ks + 1][1]};
                acc = __builtin_amdgcn_mfma_f32_16x16x32_bf16(vf, __builtin_bit_cast(bf16x8, pw), acc, 0, 0, 0); }
            u32x2 o; o.x = pkbf(acc[0] * inv, acc[1] * inv); o.y = pkbf(acc[2] * inv, acc[3] * inv);
            *(GAS u32x2*)(Ob + mq * ATT_W + a.cb + 16 * dt + 4 * kg) = o; }
    }
#undef AT_LOAD
    LDS_WAIT(); __syncthreads();
}

__device__ __forceinline__ void conv_prepass(Frame& F) {
    THREAD_COORDS();
    const bf16* XR = (const bf16*)(F.ws + WS_XR); bf16* XC = (bf16*)(F.ws + WS_XC); const float* cwp = F.in[4]; const float* cbp = F.in[5];
    for (int item = F.vcu * 512 + tid; item < (M / 8) * (D / 8); item += F.G * 512) {
        const int oct = item & 511, rg = item >> 9, m0 = rg * 8, t0 = m0 & (SEQ - 1);
        float cw[4][8], a8[8][8];
#pragma unroll
        for (int e = 0; e < 8; ++e) { const float bsv = cbp[8 * oct + e];
#pragma unroll
            for (int k = 0; k < 4; ++k) cw[k][e] = cwp[k * 4096 + 8 * oct + e];
#pragma unroll
            for (int rr = 0; rr < 8; ++rr) a8[rr][e] = bsv; }
#pragma unroll
        for (int k = 0; k < 11; ++k) { v4u xv = {0u, 0u, 0u, 0u}; if (t0 - 3 + k >= 0) xv = *(const GAS v4u*)(XR + (size_t)(m0 - 3 + k) * D + 8 * oct);
            const float x8[8] = {bf_lo(xv.x), bf_hi(xv.x), bf_lo(xv.y), bf_hi(xv.y), bf_lo(xv.z), bf_hi(xv.z), bf_lo(xv.w), bf_hi(xv.w)};
#pragma unroll
            for (int rr = 0; rr < 8; ++rr) { const int kk = k - rr; if (kk >= 0 && kk < 4) {
#pragma unroll
                for (int e = 0; e < 8; ++e) a8[rr][e] += cw[kk][e] * x8[e]; } } }
#pragma unroll
        for (int rr = 0; rr < 8; ++rr) { v4u o; o.x = pkbf(a8[rr][0], a8[rr][1]); o.y = pkbf(a8[rr][2], a8[rr][3]); o.z = pkbf(a8[rr][4], a8[rr][5]); o.w = pkbf(a8[rr][6], a8[rr][7]);
            *(GAS v4u*)(XC + (size_t)(m0 + rr) * D + 8 * oct) = o; }
    }
}
constexpr int LR_AS = 264, LR_LA_OFF = 128 * LR_AS * 2, LR_LB_OFF = LR_LA_OFF + 128 * 64 * 4, LR_CP_OFF = XH_OFF;
static_assert(LR_LB_OFF + 128 * 64 * 4 <= MISC_OFF && LR_CP_OFF + 8 * 2 * 64 * 4 <= LDS_BYTES, "LRU LDS");
__device__ __forceinline__ void lru_unit(Frame& F, int u) {
    THREAD_COORDS();
    const int b = u >> 6, n = (u >> 2) & 15, jq = u & 3, chb = n * 256, ch0 = chb + jq * 64; const size_t mb = (size_t)b * SEQ;
    const int w = wave, jt = w & 3, th = w >> 2, q = lane & 15, kg = lane >> 4;
    const bf16* XC = (const bf16*)(F.ws + WS_XC); bf16* YG = (bf16*)(F.ws + WS_YG);
    const bf16* Wrg = (const bf16*)(F.ws + WS_WRG); const bf16* Wig = (const bf16*)(F.ws + WS_WIG);
    LAS bf16* Aimg = (LAS bf16*)(F.lds); LAS float* LA = (LAS float*)(F.lds + LR_LA_OFF); LAS float* LB = (LAS float*)(F.lds + LR_LB_OFF); LAS float* CP = (LAS float*)(F.lds + LR_CP_OFF);
    const int jrow = jq * 64 + jt * 16 + q;
    bf16x8 brf[8], bif[8];
#pragma unroll
    for (int ks = 0; ks < 8; ++ks) { brf[ks] = *(const GAS bf16x8*)(Wrg + ((size_t)n * 256 + jrow) * 256 + 32 * ks + 8 * kg); bif[ks] = *(const GAS bf16x8*)(Wig + ((size_t)n * 256 + jrow) * 256 + 32 * ks + 8 * kg); }
    const float biasr = F.in[7][chb + jrow], biasi = F.in[9][chb + jrow], c1 = -8.0f * 1.4426950408889634f * log1pf(expf(-F.in[10][chb + jrow]));
    float hc = 0.f;
    v4u xcr[8];
#define LR_LOAD(T0) do { _Pragma("unroll") for (int it = 0; it < 8; ++it) { const int x = tid + 512 * it; xcr[it] = *(const GAS v4u*)(XC + (mb + (T0) + (x >> 5)) * D + chb + 8 * (x & 31)); } } while (0)
    LR_LOAD(0);
    for (int ci = 0; ci < SEQ / 128; ++ci) {
        const int t0 = ci * 128;
        { int td = tid; asm volatile("" : "+v"(td));
#pragma unroll
          for (int it = 0; it < 8; ++it) { const int x = td + 512 * it; *(LAS v4u*)(Aimg + (x >> 5) * LR_AS + 8 * (x & 31)) = xcr[it]; } }
        v4u ygr[2];
#pragma unroll
        for (int it = 0; it < 2; ++it) { const int x = tid + 512 * it; ygr[it] = *(const GAS v4u*)(YG + (mb + t0 + (x >> 3)) * D + ch0 + 8 * (x & 7)); }
        LDS_WAIT(); __syncthreads();
        if (ci + 1 < SEQ / 128) LR_LOAD(t0 + 128);
        int q_ = q, kg_ = kg; asm volatile("" : "+v"(q_), "+v"(kg_));
#pragma unroll
        for (int rt = 0; rt < 4; ++rt) { f32x4 ar = {0.f, 0.f, 0.f, 0.f}, ai = {0.f, 0.f, 0.f, 0.f};
#pragma unroll
            for (int ks = 0; ks < 8; ++ks) { const bf16x8 af = *(const LAS bf16x8*)(Aimg + (th * 64 + rt * 16 + q_) * LR_AS + 32 * ks + 8 * kg_);
                ar = __builtin_amdgcn_mfma_f32_16x16x32_bf16(af, brf[ks], ar, 0, 0, 0); ai = __builtin_amdgcn_mfma_f32_16x16x32_bf16(af, bif[ks], ai, 0, 0, 0); }
#pragma unroll
            for (int e = 0; e < 4; ++e) { const int t = th * 64 + rt * 16 + 4 * kg_ + e, jl = jt * 16 + q_;
                const float xcv = __uint_as_float(((unsigned)Aimg[t * LR_AS + jq * 64 + jl]) << 16);
                const float rr = sigmoid_f(ar[e] + biasr), ii = sigmoid_f(ai[e] + biasi), a = __builtin_amdgcn_exp2f(c1 * rr);
                LA[t * 64 + jl] = a; LB[t * 64 + jl] = __builtin_amdgcn_sqrtf(fmaxf(1.0f - a * a, 0.f)) * ii * xcv; } }
        LDS_WAIT(); __syncthreads();
        float av[16], bv[16]; int ln = lane; asm volatile("" : "+v"(ln));
#pragma unroll
        for (int s = 0; s < 16; ++s) { av[s] = LA[(16 * w + s) * 64 + ln]; bv[s] = LB[(16 * w + s) * 64 + ln]; }
        { float A = 1.f, B = 0.f;
#pragma unroll
          for (int s = 0; s < 16; ++s) { B = av[s] * B + bv[s]; A *= av[s]; }
          CP[(w * 2 + 0) * 64 + ln] = A; CP[(w * 2 + 1) * 64 + ln] = B; }
        LDS_WAIT(); __syncthreads();
        float h = hc, hin = 0.f;
#pragma unroll
        for (int s2 = 0; s2 < 8; ++s2) { const float A = CP[(s2 * 2 + 0) * 64 + ln], B = CP[(s2 * 2 + 1) * 64 + ln]; hin = (s2 == w) ? h : hin; h = A * h + B; }
        hc = h; h = hin;
#pragma unroll
        for (int s = 0; s < 16; ++s) { h = av[s] * h + bv[s]; LB[(16 * w + s) * 64 + ln] = h; }
        LDS_WAIT(); __syncthreads();
#pragma unroll
        for (int it = 0; it < 2; ++it) { int x = tid + 512 * it; asm volatile("" : "+v"(x)); const int t = x >> 3, oc = x & 7; const size_t go = (mb + t0 + t) * D + ch0 + 8 * oc;
            const f32x4 h0 = *(const LAS f32x4*)(LB + t * 64 + 8 * oc), h1 = *(const LAS f32x4*)(LB + t * 64 + 8 * oc + 4); const v4u yv = ygr[it];
            v4u o; o.x = pkbf(h0[0] * bf_lo(yv.x), h0[1] * bf_hi(yv.x)); o.y = pkbf(h0[2] * bf_lo(yv.y), h0[3] * bf_hi(yv.y));
            o.z = pkbf(h1[0] * bf_lo(yv.z), h1[1] * bf_hi(yv.z)); o.w = pkbf(h1[2] * bf_lo(yv.w), h1[3] * bf_hi(yv.w));
            *(GAS v4u*)(YG + go) = o; }
    }
#undef LR_LOAD
    LDS_WAIT(); __syncthreads();
}

__device__ __forceinline__ void combine_phase(Frame& F) {
    THREAD_COORDS();
    bf16* Ob = (bf16*)(F.ws + WS_O); const float* LSE = (const float*)(F.ws + WS_LSE);
    const int stride = F.G * 512, total = M * 128;
    for (int i0 = F.vcu * 512 + tid; i0 < total; i0 += 4 * stride) {
        v4u v[4][3]; float l[4][3];
#pragma unroll
        for (int k = 0; k < 4; ++k) { const int i = i0 + k * stride; if (i < total) { const size_t m = (size_t)(i >> 7); const int hd = i & 127, h = hd >> 4;
#pragma unroll
            for (int g = 0; g < 3; ++g) { l[k][g] = LSE[m * 24 + g * 8 + h]; v[k][g] = *(const GAS v4u*)(Ob + m * ATT_W + g * 1024 + hd * 8); } } }
#pragma unroll
        for (int k = 0; k < 4; ++k) { const int i = i0 + k * stride; if (i < total) { const size_t m = (size_t)(i >> 7); const int hd = i & 127;
            const float mx = fmaxf(l[k][0], fmaxf(l[k][1], l[k][2])); float e[3]; e[0] = __expf(l[k][0] - mx); e[1] = __expf(l[k][1] - mx); e[2] = __expf(l[k][2] - mx); const float rs = 1.0f / (e[0] + e[1] + e[2]);
#pragma unroll
            for (int g = 0; g < 3; ++g) { const float wgt = e[g] * rs; const v4u x = v[k][g]; v4u o;
                o.x = pkbf(bf_lo(x.x) * wgt, bf_hi(x.x) * wgt); o.y = pkbf(bf_lo(x.y) * wgt, bf_hi(x.y) * wgt); o.z = pkbf(bf_lo(x.z) * wgt, bf_hi(x.z) * wgt); o.w = pkbf(bf_lo(x.w) * wgt, bf_hi(x.w) * wgt);
                *(GAS v4u*)(Ob + m * ATT_W + g * 1024 + hd * 8) = o; } } }
    }
}
__device__ __forceinline__ void fixup_phase(Frame& F) {
    THREAD_COORDS();
    const float* HALO = (const float*)(F.ws + WS_HALO); const float* HEAD = (const float*)(F.ws + WS_HEAD); bf16* ACT = (bf16*)(F.ws + WS_ACT);
    const float* cw = F.in[16]; const float* cb = F.in[17];
    const int total = 64 * (FFN / 4);
    for (int i = F.vcu * 512 + tid; i < total; i += F.G * 512) {
        const int G = (i % (FFN / 4)) * 4, pm = i / (FFN / 4); if ((pm & 15) == 0) continue;
        const int pn = G >> 7, gi = G & 127, cg = pn * 256 + gi, cv = cg + 128;
        const float* hp = HALO + (size_t)(pm - 1) * 2 * 24576; const float* hd = HEAD + (size_t)pm * 2 * 24576;
        f32x4 ug[4], uv[4], wg[3], wv[3];
        ug[0] = *(const GAS f32x4*)(hp + cg); ug[1] = *(const GAS f32x4*)(hp + 24576 + cg); ug[2] = *(const GAS f32x4*)(hd + cg); ug[3] = *(const GAS f32x4*)(hd + 24576 + cg);
        uv[0] = *(const GAS f32x4*)(hp + cv); uv[1] = *(const GAS f32x4*)(hp + 24576 + cv); uv[2] = *(const GAS f32x4*)(hd + cv); uv[3] = *(const GAS f32x4*)(hd + 24576 + cv);
#pragma unroll
        for (int k = 0; k < 3; ++k) { wg[k] = *(const GAS f32x4*)(cw + k * 24576 + G); wv[k] = *(const GAS f32x4*)(cw + k * 24576 + FFN + G); }
        const f32x4 bg = *(const GAS f32x4*)(cb + G), bv = *(const GAS f32x4*)(cb + FFN + G);
#pragma unroll
        for (int rr = 0; rr < 2; ++rr) { const f32x4 yg = wg[0] * ug[rr] + wg[1] * ug[rr + 1] + wg[2] * ug[rr + 2] + bg, yv = wv[0] * uv[rr] + wv[1] * uv[rr + 1] + wv[2] * uv[rr + 2] + bv;
            u32x2 o; o.x = pkbf(gelu_tanh_f(yg[0]) * yv[0], gelu_tanh_f(yg[1]) * yv[1]); o.y = pkbf(gelu_tanh_f(yg[2]) * yv[2], gelu_tanh_f(yg[3]) * yv[3]);
            *(GAS u32x2*)(ACT + (size_t)(pm * 256 + rr) * FFN + G) = o; }
    }
}
__device__ __forceinline__ void final_phase(Frame& F) {
    THREAD_COORDS();
    const int gw = F.vcu * NWAVES + wave, NGW = F.G * NWAVES; const float* rss3 = (const float*)(F.ws + WS_CTL + CTL_RSS3); const GAS f32x4* gf = (const GAS f32x4*)F.in[23] + lane;
    for (int m = gw; m < M; m += NGW) { const float rs = rstd_of(rss3[m]); GAS f32x4* o = (GAS f32x4*)(F.out + (size_t)m * D) + lane;
#pragma unroll
        for (int j = 0; j < 16; ++j) { const f32x4 v = o[64 * j], g = gf[64 * j]; o[64 * j] = v * rs * g; } }
}

struct Args { const float* in[24]; float* out; unsigned char* ws; int ph_lo, ph_hi, li, pad; };
static_assert(WS_K - WS_Q == 96 * MiB && WS_V - WS_K == 96 * MiB && WS_YG - WS_XR == 128 * MiB && WS_GA - WS_YG == 128 * MiB && WS_GR - WS_GA == 128 * MiB, "EpiProj strides");
__global__ void __launch_bounds__(NWAVES * 64, 2) fwd_kernel(const Args args) {
    extern __shared__ __attribute__((aligned(16))) unsigned char lds[];
    Frame F;
    F.lds = (LAS unsigned char*)lds; F.MISC = (volatile LAS unsigned*)(F.lds + MISC_OFF);
    F.wave = __builtin_amdgcn_readfirstlane((int)threadIdx.x >> 6);
    F.G = gridDim.x; { const int bx = blockIdx.x; F.vcu = (F.G % 8 == 0) ? (bx % 8) * (F.G / 8) + bx / 8 : bx; }
    F.ws = args.ws; F.ctl = (gu32*)(args.ws + WS_CTL); F.out = args.out;
    F.in = args.in;
    for (int u = (int)threadIdx.x; u < 128; u += NWAVES * 64) ((LAS unsigned*)(F.lds + MISC_OFF))[u] = 0u;
    __syncthreads();
    XcdBarrier bar; bar.bar = (unsigned*)(F.ctl + CW_BAR); bar.x = 0; bar.st = nullptr;
    if (N_LAUNCHES == 1) bar = xcd_barrier_post((unsigned*)(F.ctl + CW_BAR), F.MISC + 8, threadIdx.x == 0);
#if defined(PROBE_A)
    int nst = 0;
#define STAMP() do { if (F.wave == 0 && opaque_lane() == 0) { const unsigned long long t_ = __builtin_amdgcn_s_memrealtime(); F.MISC[32 + 2 * nst] = (unsigned)t_; F.MISC[33 + 2 * nst] = (unsigned)(t_ >> 32); } ++nst; } while (0)
#define TST(k) (((unsigned long long)F.MISC[33 + 2 * (k)] << 32) | F.MISC[32 + 2 * (k)])
#else
#define STAMP() do { } while (0)
#endif
#define GRID_BAR() do { if (N_LAUNCHES == 1) xcd_barrier(bar, F.wave == 0 && opaque_lane() == 0); STAMP(); } while (0)
    const int lo = args.ph_lo, hi = args.ph_hi;
#define IN(k) (lo <= (k) && (k) < hi)
#define BOTH(k) (IN(k) && IN((k) + 1))
    unsigned char* ws = args.ws;
    float* rss0 = (float*)(ws + WS_CTL + CTL_RSS0); float* rss1 = (float*)(ws + WS_CTL + CTL_RSS1); float* rss2 = (float*)(ws + WS_CTL + CTL_RSS2);
    float* rss3 = (float*)(ws + WS_CTL + CTL_RSS3); float* rsse = (float*)(ws + WS_CTL + CTL_RSSE);
    const int c = (int)blockIdx.x;

    STAMP();
#if defined(DUP_P0)
    if (IN(0)) { p0_prologue(F); GRID_BAR(); }
#endif
    if (IN(0)) { p0_prologue(F); if (BOTH(0)) GRID_BAR(); }
#define RUN_P1(LASTBAR) do { \
        pg8::Gemm g{(const bf16*)(ws + WS_XB), (const bf16*)(ws + WS_WIN), M, IN_COLS, D}; pg8::StaticOrder S; S.init(M, IN_COLS, F.G, c); \
        pg8::EpiProj E{(bf16*)(ws + WS_Q), (bf16*)(ws + WS_XR), rss0}; \
        pg8::gemm_phase<pg8::EpiProj, pg8::StaticOrder, true, true>(F.lds + RING_OFF, g, S, E, F.wave); \
        if (LASTBAR) GRID_BAR(); } while (0)
#if defined(DUP_P1)
    if (IN(1)) RUN_P1(true);
#endif
    if (IN(1)) RUN_P1(BOTH(1));
#if defined(DUP_P2)
    for (int rep = 0; rep < 2; ++rep)
#endif
    if (IN(2)) {
        conv_prepass(F);
        const int per = (3072 + F.G - 1) / F.G; { const int first = F.vcu * per; int cnt = 3072 - first; cnt = cnt > per ? per : cnt; if (cnt > 0) attn_units(F, first, cnt); }
        if (BOTH(2)) GRID_BAR();
    }
    if (IN(3)) {
        for (int u = F.vcu; u < 256; u += F.G) lru_unit(F, u);
        combine_phase(F);
        if (BOTH(3)) GRID_BAR();
    }
    if (IN(4)) {
        { pg8::Gemm g{(const bf16*)(ws + WS_O), (const bf16*)(ws + WS_WATT), M, D, ATT_W}; pg8::StaticOrder S; S.init(M, D, F.G, c);
          pg8::EpiGateT E{(const bf16*)(ws + WS_GA), (float*)(ws + WS_T)};
          pg8::gemm_phase<pg8::EpiGateT, pg8::StaticOrder, true, true>(F.lds + RING_OFF, g, S, E, F.wave); }
        { pg8::Gemm g{(const bf16*)(ws + WS_LRU), (const bf16*)(ws + WS_WLRU), M, D, D}; pg8::StaticOrder S; S.init(M, D, F.G, c);
          pg8::EpiMerge E{(const bf16*)(ws + WS_GR), (const float*)(ws + WS_T), (bf16*)(ws + WS_MRG)};
          pg8::gemm_phase<pg8::EpiMerge, pg8::StaticOrder, true, true>(F.lds + RING_OFF, g, S, E, F.wave); }
        if (BOTH(4)) GRID_BAR();
    }
    if (IN(5)) {
        { pg8::Gemm g{(const bf16*)(ws + WS_MRG), (const bf16*)(ws + WS_WOUT), M, D, D}; pg8::StaticOrder S; S.init(M, D, F.G, c);
          pg8::EpiResid E{F.in[0], (float*)(ws + WS_X1), (bf16*)(ws + WS_X1B), rss1};
          pg8::gemm_phase<pg8::EpiResid, pg8::StaticOrder, true, true>(F.lds + RING_OFF, g, S, E, F.wave); }
        { pg8::Gemm g{(const bf16*)(ws + WS_PB), (const bf16*)(ws + WS_WPP), M, D, PLE}; pg8::StaticOrder S; S.init(M, D, F.G, c);
          pg8::EpiBf16Stat E{(bf16*)(ws + WS_ERAW), rsse};
          pg8::gemm_phase<pg8::EpiBf16Stat, pg8::StaticOrder, true, true>(F.lds + RING_OFF, g, S, E, F.wave); }
        if (BOTH(5)) GRID_BAR();
    }
    if (IN(6)) {
        pg8::Gemm g{(const bf16*)(ws + WS_X1B), (const bf16*)(ws + WS_WUP), M, 2 * FFN, D}; pg8::StaticOrder S; S.init(M, 2 * FFN, F.G, c);
        pg8::EpiUpConv E{rss1, F.in[16], F.in[17], (bf16*)(ws + WS_ACT), (float*)(ws + WS_HALO), (float*)(ws + WS_HEAD), (LAS float*)(F.lds + XH_OFF)};
        pg8::gemm_phase<pg8::EpiUpConv, pg8::StaticOrder, true, true>(F.lds + RING_OFF, g, S, E, F.wave);
        if (BOTH(6)) GRID_BAR();
    }
    if (IN(7)) { fixup_phase(F); if (BOTH(7)) GRID_BAR(); }
    if (IN(8)) {
        pg8::Gemm g{(const bf16*)(ws + WS_ACT), (const bf16*)(ws + WS_WDOWN), M, D, FFN}; pg8::StaticOrder S; S.init(M, D, F.G, c);
        pg8::EpiResid E{(const float*)(ws + WS_X1), (float*)(ws + WS_X1), (bf16*)(ws + WS_X2B), rss2};
        pg8::gemm_phase<pg8::EpiResid, pg8::StaticOrder, true, true>(F.lds + RING_OFF, g, S, E, F.wave);
        if (BOTH(8)) GRID_BAR();
    }
    if (IN(9)) {
        pg8::Gemm g{(const bf16*)(ws + WS_X2B), (const bf16*)(ws + WS_WPG), M, D, D}; pg8::StaticOrder S; S.init(M, D, F.G, c);
        pg8::EpiPle E{(const float*)(ws + WS_X1), (const bf16*)(ws + WS_ERAW), rss2, rsse, F.in[20], F.out, rss3};
        pg8::gemm_phase<pg8::EpiPle, pg8::StaticOrder, true, true>(F.lds + RING_OFF, g, S, E, F.wave);
        if (BOTH(9)) GRID_BAR();
    }
    if (IN(10)) final_phase(F);
#if defined(PROBE_A)
    STAMP();
    if (blockIdx.x == 0) {
        __syncthreads(); const float ta = (float)(TST(PROBE_A + 1) - TST(PROBE_A)) * 0.01f, tb = (float)(TST(PROBE_B + 1) - TST(PROBE_B)) * 0.001f;
        asm volatile("s_waitcnt vmcnt(0)" ::: "memory");
        const int lane = opaque_lane();
        if (F.wave == 0) { for (int m = 0; m < M; m += F.G * NWAVES) for (int j = lane; j < D; j += 64) F.out[(size_t)m * D + j] += tb;
        asm volatile("s_waitcnt vmcnt(0)" ::: "memory");
        if (lane == 0) F.out[0] += ta; }
    }
#endif
#undef IN
#undef BOTH
#undef GRID_BAR
}

extern "C" void kernel_launch(void* const* d_in, const int* in_sizes, int n_in, void* d_out, int out_size, void* d_ws, size_t ws_size, hipStream_t stream) {
    static int grid = 0;
    if (grid == 0) {
        if (n_in != 24 || in_sizes[0] != M * D || out_size != M * D || ws_size < WS_END) { fprintf(stderr, "kernel_launch: unexpected problem (n_in %d, in0 %d, out %d, ws %zu < %zu); nothing launched\n", n_in, n_in > 0 ? in_sizes[0] : -1, out_size, ws_size, (size_t)WS_END); grid = -1; return; }
        int dev = 0, cus = 0, per_cu = 0;
        if (hipGetDevice(&dev) != hipSuccess || hipDeviceGetAttribute(&cus, hipDeviceAttributeMultiprocessorCount, dev) != hipSuccess) { fprintf(stderr, "kernel_launch: device query failed\n"); grid = -1; return; }
        if (hipFuncSetAttribute((const void*)fwd_kernel, hipFuncAttributeMaxDynamicSharedMemorySize, LDS_BYTES) != hipSuccess) { fprintf(stderr, "kernel_launch: hipFuncSetAttribute failed\n"); grid = -1; return; }
        if (hipOccupancyMaxActiveBlocksPerMultiprocessor(&per_cu, (const void*)fwd_kernel, NWAVES * 64, LDS_BYTES) != hipSuccess || per_cu < 1) fprintf(stderr, "kernel_launch: note: occupancy query reports %d workgroups per CU\n", per_cu);
        (void)hipGetLastError();
        grid = cus;
    }
    if (grid < 0) return;
    if (hipMemsetAsync((char*)d_ws + WS_CTL, 0, CTL_ZERO_BYTES, stream) != hipSuccess) { fprintf(stderr, "kernel_launch: memset failed\n"); return; }
    Args a{};
    for (int i = 0; i < 24; ++i) a.in[i] = (const float*)d_in[i];
    a.out = (float*)d_out; a.ws = (unsigned char*)d_ws;
    for (int li = 0; li < N_LAUNCHES; ++li) {
        a.ph_lo = (N_LAUNCHES == 1) ? 0 : li; a.ph_hi = (N_LAUNCHES == 1) ? NPH : li + 1; a.li = li; a.pad = 0;
        hipLaunchKernelGGL(fwd_kernel, dim3(grid), dim3(NWAVES * 64), LDS_BYTES, stream, a);
        const hipError_t le = hipPeekAtLastError();
        if (le != hipSuccess) { fprintf(stderr, "kernel_launch: launch %d failed: %s\n", li, hipGetErrorName(le)); break; }
    }
}
```
